# Optimizing an MI355X kernel written in HIP

```python
import jax, jax.numpy as jnp
from jax import lax
import numpy as np

D_MODEL = 1024
BATCH = 8
SEQ = 2048
DEPTH = 2
DEC_BATCH = 32
DEC_SEQ = 64
PAST_LEN = 2048

CHUNK = 64
N_MIXERS = 2
N_SSD_LAYERS = (DEPTH + 1) // 2
N_CMLP_LAYERS = DEPTH // 2
SSD_D_INNER = 2 * D_MODEL
SSD_HEAD_DIM = 64
SSD_HEADS = SSD_D_INNER // SSD_HEAD_DIM
SSD_GROUPS = 8
SSD_STATE = 128
SSD_CONV = 4
SSD_CONV_DIM = SSD_D_INNER + 2 * SSD_GROUPS * SSD_STATE
SSD_IN_DIM = SSD_D_INNER + SSD_CONV_DIM + SSD_HEADS
CM_BLOCK = 128
CM_WIDTH = 2 * D_MODEL
CM_GROUPS = 8
FFN_HIDDEN = 4 * D_MODEL
DN_ALPHA = (2 * DEPTH) ** 0.25
DN_BETA = (8 * DEPTH) ** -0.25
LN_EPS = 1e-5

kernel_name = "hybrid_ssd_chunk_gmlp_streaming_step"


def layer_norm(x, g, b):
    xf = x.astype(jnp.float32)
    mu = jnp.mean(xf, axis=-1, keepdims=True)
    var = jnp.mean(jnp.square(xf - mu), axis=-1, keepdims=True)
    return ((xf - mu) * lax.rsqrt(var + LN_EPS) * g + b).astype(x.dtype)


def causal_conv_silu(xbc, prev, w, b):
    L = xbc.shape[1]
    full = jnp.concatenate([prev.astype(xbc.dtype), xbc], axis=1)
    acc = full[:, 0:L] * w[0]
    for k in range(1, SSD_CONV):
        acc = acc + full[:, k:k + L] * w[k]
    return jax.nn.silu(acc + b), full[:, -(SSD_CONV - 1):]


def ssd_scan(xh, dt, A, Bm, Cm, h0):
    b, L, H, P = xh.shape
    G, N = Bm.shape[2], Bm.shape[3]
    R = H // G
    Q = CHUNK if L % CHUNK == 0 else L
    nc = L // Q

    def to_blocks(t):
        return jnp.moveaxis(t.reshape((b, nc, Q) + t.shape[2:]), 1, 0)

    xdt = (xh.astype(jnp.float32) * dt[..., None]).reshape(b, L, G, R, P)
    dA = (dt * A).reshape(b, L, G, R)
    xs = (to_blocks(xdt), to_blocks(dA), to_blocks(Bm.astype(jnp.float32)), to_blocks(Cm.astype(jnp.float32)))
    causal = jnp.tril(jnp.ones((Q, Q), dtype=bool))[None, :, :, None, None]

    def step(h, inp):
        xc, dac, bc, cc = inp
        acum = jnp.cumsum(dac, axis=1)
        seg = acum[:, :, None] - acum[:, None, :]
        decay = jnp.exp(jnp.where(causal, seg, -jnp.inf))
        cb = jnp.einsum('btgn,bsgn->btsg', cc, bc)
        y_diag = jnp.einsum('btsg,btsgr,bsgrp->btgrp', cb, decay, xc)
        y_off = jnp.einsum('btgn,bgrpn,btgr->btgrp', cc, h, jnp.exp(acum))
        a_last = acum[:, -1]
        w_in = jnp.exp(a_last[:, None] - acum)
        h_new = h * jnp.exp(a_last)[..., None, None] + jnp.einsum('bsgn,bsgr,bsgrp->bgrpn', bc, w_in, xc)
        return h_new, y_diag + y_off

    hT, ys = lax.scan(step, h0.astype(jnp.float32).reshape(b, G, R, P, N), xs)
    y = jnp.moveaxis(ys, 0, 1).reshape(b, L, H, P)
    return y, hT.reshape(b, H, P, N)


def ssd_mixer(x, conv_prev, h0, w_in, conv_w, conv_b, dt_bias, a_log, d_skip, norm_w, w_out):
    b, L, _ = x.shape
    proj = x @ w_in
    z = proj[..., :SSD_D_INNER]
    xbc = proj[..., SSD_D_INNER:SSD_D_INNER + SSD_CONV_DIM]
    dt_raw = proj[..., SSD_D_INNER + SSD_CONV_DIM:]
    xbc, conv_new = causal_conv_silu(xbc, conv_prev, conv_w, conv_b)
    xs = xbc[..., :SSD_D_INNER].reshape(b, L, SSD_HEADS, SSD_HEAD_DIM)
    Bm = xbc[..., SSD_D_INNER:SSD_D_INNER + SSD_GROUPS * SSD_STATE].reshape(b, L, SSD_GROUPS, SSD_STATE)
    Cm = xbc[..., SSD_D_INNER + SSD_GROUPS * SSD_STATE:].reshape(b, L, SSD_GROUPS, SSD_STATE)
    dt = jax.nn.softplus(dt_raw.astype(jnp.float32) + dt_bias.astype(jnp.float32))
    A = -jnp.exp(a_log.astype(jnp.float32))
    y, hT = ssd_scan(xs, dt, A, Bm, Cm, h0)
    y = y + d_skip.astype(jnp.float32)[:, None] * xs.astype(jnp.float32)
    g = y.reshape(b, L, SSD_D_INNER) * jax.nn.silu(z.astype(jnp.float32))
    gg = g.reshape(b, L, SSD_GROUPS, SSD_D_INNER // SSD_GROUPS)
    gg = gg * lax.rsqrt(jnp.mean(jnp.square(gg), axis=-1, keepdims=True) + LN_EPS)
    normed = (gg.reshape(b, L, SSD_D_INNER) * norm_w).astype(x.dtype)
    return normed @ w_out, conv_new, hT.astype(h0.dtype)


def chunk_mlp_mixer(x, w_in, b_in, ln_g, ln_b, w_s, b_s, w_out):
    b, L, _ = x.shape
    h = jax.nn.gelu(x @ w_in + b_in)
    u, v = h[..., :CM_WIDTH], h[..., CM_WIDTH:]
    v = layer_norm(v, ln_g, ln_b)
    nb = L // CM_BLOCK if L % CM_BLOCK == 0 else 1
    blk = L // nb
    mask = jnp.tril(jnp.ones((blk, blk), dtype=bool))
    ws = jnp.where(mask, w_s[:, :blk, :blk], 0.0)
    vb = v.reshape(b, nb, blk, CM_GROUPS, CM_WIDTH // CM_GROUPS)
    s = jnp.einsum('gts,bnsgc->bntgc', ws, vb) + jnp.swapaxes(b_s[:, :blk], 0, 1)[None, None, :, :, None]
    out = u * s.reshape(b, L, CM_WIDTH)
    return out @ w_out, v


def sq_relu_ffn(x, w1, w2):
    return jnp.square(jax.nn.relu(x @ w1)) @ w2


def run_trunk(x, conv_prev, h0, ssd_w_in, ssd_conv_w, ssd_conv_b, ssd_dt_bias, ssd_a_log, ssd_d, ssd_norm_w, ssd_w_out,
              cm_w_in, cm_b_in, cm_ln_g, cm_ln_b, cm_w_s, cm_b_s, cm_w_out, ffn_w1, ffn_w2, ln1_g, ln1_b, ln2_g, ln2_b):
    conv_out, h_out, v_out = [], [], []
    for i in range(DEPTH):
        j = i // N_MIXERS
        if i % N_MIXERS == 0:
            mix, c_new, h_new = ssd_mixer(x, conv_prev[j], h0[j], ssd_w_in[j], ssd_conv_w[j], ssd_conv_b[j], ssd_dt_bias[j],
                                          ssd_a_log[j], ssd_d[j], ssd_norm_w[j], ssd_w_out[j])
            conv_out.append(c_new)
            h_out.append(h_new)
        else:
            mix, v_rows = chunk_mlp_mixer(x, cm_w_in[j], cm_b_in[j], cm_ln_g[j], cm_ln_b[j], cm_w_s[j], cm_b_s[j], cm_w_out[j])
            v_out.append(v_rows)
        x = layer_norm(DN_ALPHA * x + mix, ln1_g[i], ln1_b[i])
        x = layer_norm(DN_ALPHA * x + sq_relu_ffn(x, ffn_w1[i], ffn_w2[i]), ln2_g[i], ln2_b[i])
    return x, conv_out, h_out, v_out


def setup_inputs(seed: int = 0) -> dict:
    key = jax.random.key(seed)
    ks = jax.random.split(key, 32)
    f32 = jnp.float32

    def nrm(k, shape, scale):
        return jax.random.normal(k, shape, f32) * scale

    nS, nC = N_SSD_LAYERS, N_CMLP_LAYERS
    dt0 = jnp.exp(jax.random.uniform(ks[8], (nS, SSD_HEADS), f32, np.log(1e-3), np.log(1e-1)))
    dt_bias = dt0 + jnp.log(-jnp.expm1(-dt0))
    return {
        "x_prompt": nrm(ks[0], (BATCH, SEQ, D_MODEL), 1.0),
        "x_sample": nrm(ks[1], (DEC_BATCH, DEC_SEQ, D_MODEL), 1.0),
        "state_ssm": nrm(ks[2], (nS, DEC_BATCH, SSD_HEADS, SSD_HEAD_DIM, SSD_STATE), 0.5),
        "state_conv": nrm(ks[3], (nS, DEC_BATCH, SSD_CONV - 1, SSD_CONV_DIM), 1.0),
        "ssd_w_in": nrm(ks[4], (nS, D_MODEL, SSD_IN_DIM), D_MODEL ** -0.5),
        "ssd_conv_w": nrm(ks[5], (nS, SSD_CONV, SSD_CONV_DIM), SSD_CONV ** -0.5),
        "ssd_conv_b": nrm(ks[6], (nS, SSD_CONV_DIM), 0.02),
        "ssd_dt_bias": dt_bias,
        "ssd_a_log": jnp.log(jax.random.uniform(ks[9], (nS, SSD_HEADS), f32, 1.0, 16.0)),
        "ssd_d": 1.0 + nrm(ks[10], (nS, SSD_HEADS), 0.1),
        "ssd_norm_w": 1.0 + nrm(ks[11], (nS, SSD_D_INNER), 0.02),
        "ssd_w_out": nrm(ks[12], (nS, SSD_D_INNER, D_MODEL), SSD_D_INNER ** -0.5 * DN_BETA),
        "cm_w_in": nrm(ks[13], (nC, D_MODEL, 2 * CM_WIDTH), D_MODEL ** -0.5),
        "cm_b_in": nrm(ks[14], (nC, 2 * CM_WIDTH), 0.02),
        "cm_ln_g": 1.0 + nrm(ks[15], (nC, CM_WIDTH), 0.02),
        "cm_ln_b": nrm(ks[16], (nC, CM_WIDTH), 0.02),
        "cm_w_s": nrm(ks[17], (nC, CM_GROUPS, CM_BLOCK, CM_BLOCK), CM_BLOCK ** -0.5),
        "cm_b_s": 1.0 + nrm(ks[18], (nC, CM_GROUPS, CM_BLOCK), 0.1),
        "cm_w_out": nrm(ks[19], (nC, CM_WIDTH, D_MODEL), CM_WIDTH ** -0.5 * DN_BETA),
        "ffn_w1": nrm(ks[20], (DEPTH, D_MODEL, FFN_HIDDEN), D_MODEL ** -0.5),
        "ffn_w2": nrm(ks[21], (DEPTH, FFN_HIDDEN, D_MODEL), FFN_HIDDEN ** -0.5 * DN_BETA),
        "ln1_g": 1.0 + nrm(ks[22], (DEPTH, D_MODEL), 0.02),
        "ln1_b": nrm(ks[23], (DEPTH, D_MODEL), 0.02),
        "ln2_g": 1.0 + nrm(ks[24], (DEPTH, D_MODEL), 0.02),
        "ln2_b": nrm(ks[25], (DEPTH, D_MODEL), 0.02),
    }


def reference(x_prompt, x_sample, state_ssm, state_conv, ssd_w_in, ssd_conv_w, ssd_conv_b, ssd_dt_bias, ssd_a_log, ssd_d,
              ssd_norm_w, ssd_w_out, cm_w_in, cm_b_in, cm_ln_g, cm_ln_b, cm_w_s, cm_b_s, cm_w_out, ffn_w1, ffn_w2,
              ln1_g, ln1_b, ln2_g, ln2_b):
    weights = (ssd_w_in, ssd_conv_w, ssd_conv_b, ssd_dt_bias, ssd_a_log, ssd_d, ssd_norm_w, ssd_w_out,
               cm_w_in, cm_b_in, cm_ln_g, cm_ln_b, cm_w_s, cm_b_s, cm_w_out, ffn_w1, ffn_w2, ln1_g, ln1_b, ln2_g, ln2_b)
    b_p = x_prompt.shape[0]
    conv0 = jnp.zeros((N_SSD_LAYERS, b_p, SSD_CONV - 1, SSD_CONV_DIM), x_prompt.dtype)
    h00 = jnp.zeros((N_SSD_LAYERS, b_p, SSD_HEADS, SSD_HEAD_DIM, SSD_STATE), x_prompt.dtype)
    y_prompt, conv_p, h_p, _ = run_trunk(x_prompt, conv0, h00, *weights)
    y_sample, conv_s, h_s, v_s = run_trunk(x_sample, state_conv, state_ssm, *weights)
    ssm_prompt = jnp.stack(h_p)
    conv_prompt = jnp.stack(conv_p)
    ssm_sample = jnp.stack(h_s)
    conv_sample = jnp.stack(conv_s)
    v_rows_sample = jnp.stack(v_s)
    return (y_prompt, y_sample, ssm_prompt, conv_prompt, ssm_sample, conv_sample, v_rows_sample)
```

```cpp
#include <hip/hip_runtime.h>
#include <hip/hip_cooperative_groups.h>
#include <cstdio>
#include <cstdint>
namespace cg = cooperative_groups;
#ifndef PHMASK
#define PHMASK 0x1ffff
#endif
#ifndef ONE_LAUNCH
#define ONE_LAUNCH 1
#endif
namespace pg8 {
#define PG8_LAS __attribute__((address_space(3)))
typedef unsigned short bf16_t;
typedef short bf16x8 __attribute__((ext_vector_type(8)));
typedef float f32x4 __attribute__((ext_vector_type(4)));
typedef unsigned u32x4 __attribute__((ext_vector_type(4)));
constexpr int BM = 256, BK = 64, HALF = 128, HTB = HALF * BK * 2  , STAGE_BYTES = 8 * HTB, NXCD = 8, WGM = 8;

__host__ __device__ __forceinline__ int lds_byte(int r, int c) { const int st = (r >> 4) * 2 + (c >> 5), rr = r & 15, cc = c & 31, ob = rr * 64 + cc * 2; return st * 1024 + (ob ^ (((ob >> 9) & 1) << 5)); }
__host__ __device__ __forceinline__ void stage_rc(int b, int& R, int& C) { const int st = b / 1024, sb = b % 1024, swz = sb ^ (((sb >> 9) & 1) << 5); R = (st >> 1) * 16 + swz / 64; C = (st & 1) * 32 + (swz % 64) / 2; }
__host__ __device__ __forceinline__ int perm32(int rho) { const int n = rho >> 4, i = rho & 15; return 8 * (i >> 2) + 4 * n + (i & 3); }

struct Unit { int pm, pn; };
struct Gemm { const bf16_t* A; const bf16_t* Bt; int M, N, K, lda; };

struct StaticOrder {
    int nM, nN, nwg, G, c;
    __host__ __device__ void init(int M, int N, int G_, int c_) { nM = M / BM; nN = N / BM; nwg = nM * nN; G = G_; c = c_; }
    __host__ __device__ bool next(int i, Unit& u) const {
        const long L = (long)i * G + c; if (L >= nwg) return false;
        int wgid = (int)L; { const int q = nwg / NXCD, r = nwg % NXCD, xcd = wgid % NXCD, off = wgid / NXCD; wgid = (xcd < r ? xcd * (q + 1) : r * (q + 1) + (xcd - r) * q) + off; }
        const int nig = WGM * nN, gid = wgid / nig, fm = gid * WGM, gsz = (nM - fm) < WGM ? (nM - fm) : WGM;
        u.pm = fm + ((wgid % nig) % gsz); u.pn = (wgid % nig) / gsz; return true;
    }
    __device__ __forceinline__ void a_ready(const Unit&) const {}
    __device__ __forceinline__ void done(const Unit&) const {}
};
__device__ __forceinline__ unsigned cvt_pk_bf16(float lo, float hi) { unsigned r; asm volatile("v_cvt_pk_bf16_f32 %0, %1, %2" : "=v"(r) : "v"(lo), "v"(hi)); return r; }

constexpr int TP_ROWS = 16384;
struct EpiG1 {
    static constexpr bool PERM = true, AFTER_DRAIN = false;
    bf16_t* Z; bf16_t* XBC;
    __device__ __forceinline__ void operator()(const f32x4 (&acc)[2][2][4][2], const Unit& u, int wr, int wc, int fr, int fq) const {
        const int row0 = u.pm * BM + wr * 64 + fr; const int colt = u.pn * BM;
        const bool isx = colt >= 2048;
        bf16_t* base = isx ? XBC : Z; const int ldc = isx ? 4096 : 2048; const int col0 = (isx ? colt - 2048 : colt) + wc * 32 + 8 * fq;
#pragma unroll
        for (int ai = 0; ai < 2; ++ai)
#pragma unroll
            for (int m = 0; m < 4; ++m) { bf16_t* rowp = base + (size_t)(row0 + ai * HALF + m * 16) * ldc + col0;
#pragma unroll
                for (int bj = 0; bj < 2; ++bj) { const f32x4 v0 = acc[ai][bj][m][0], v1 = acc[ai][bj][m][1];
                    u32x4 w; w.x = cvt_pk_bf16(v0[0], v0[1]); w.y = cvt_pk_bf16(v0[2], v0[3]); w.z = cvt_pk_bf16(v1[0], v1[1]); w.w = cvt_pk_bf16(v1[2], v1[3]);
                    *(u32x4*)(rowp + bj * HALF) = w; } }
    }
};
__device__ __forceinline__ float act_relu2(float v) { const float r = v > 0.f ? v : 0.f; return r * r; }
__device__ __forceinline__ float act_gelu_tanh(float v) { const float u = 0.7978845608f * (v + 0.044715f * v * v * v); return v / (1.0f + __expf(-2.0f * u)); }
template <int ACT> struct EpiAct {
    static constexpr bool PERM = true, AFTER_DRAIN = false;
    bf16_t* O; int ldc; const float* bias;
    __device__ __forceinline__ void operator()(const f32x4 (&acc)[2][2][4][2], const Unit& u, int wr, int wc, int fr, int fq) const {
        const int row0 = u.pm * BM + wr * 64 + fr; const int col0 = u.pn * BM + wc * 32 + 8 * fq;
        f32x4 bv[2][2];
#pragma unroll
        for (int bj = 0; bj < 2; ++bj)
#pragma unroll
            for (int n = 0; n < 2; ++n) bv[bj][n] = (ACT == 2) ? *(const f32x4*)(bias + col0 + bj * HALF + 4 * n) : (f32x4){0.f, 0.f, 0.f, 0.f};
#pragma unroll
        for (int ai = 0; ai < 2; ++ai)
#pragma unroll
            for (int m = 0; m < 4; ++m) { bf16_t* rowp = O + (size_t)(row0 + ai * HALF + m * 16) * ldc + col0;
#pragma unroll
                for (int bj = 0; bj < 2; ++bj) { f32x4 v0 = acc[ai][bj][m][0] + bv[bj][0], v1 = acc[ai][bj][m][1] + bv[bj][1];
#pragma unroll
                    for (int j = 0; j < 4; ++j) { if (ACT == 1) { v0[j] = act_relu2(v0[j]); v1[j] = act_relu2(v1[j]); } else { v0[j] = act_gelu_tanh(v0[j]); v1[j] = act_gelu_tanh(v1[j]); } }
                    u32x4 w; w.x = cvt_pk_bf16(v0[0], v0[1]); w.y = cvt_pk_bf16(v0[2], v0[3]); w.z = cvt_pk_bf16(v1[0], v1[1]); w.w = cvt_pk_bf16(v1[2], v1[3]);
                    *(u32x4*)(rowp + bj * HALF) = w; } }
    }
};
struct EpiRes {
    static constexpr bool PERM = false, AFTER_DRAIN = false;
    const float* resP; const float* resS; float* out; float alpha;
    __device__ __forceinline__ void operator()(const f32x4 (&acc)[2][2][4][2], const Unit& u, int wr, int wc, int fr, int fq) const {
        const int row0 = u.pm * BM + wr * 64 + fr, col0 = u.pn * BM + wc * 32 + 4 * fq;
#pragma unroll
        for (int ai = 0; ai < 2; ++ai)
#pragma unroll
            for (int m = 0; m < 4; ++m) { const int row = row0 + ai * HALF + m * 16;
                const float* rp = (row < TP_ROWS ? resP + (size_t)row * 1024 : resS + (size_t)(row - TP_ROWS) * 1024) + col0; float* op = out + (size_t)row * 1024 + col0;
#pragma unroll
                for (int bj = 0; bj < 2; ++bj)
#pragma unroll
                    for (int n = 0; n < 2; ++n) { const f32x4 r = *(const f32x4*)(rp + bj * HALF + n * 16); *(f32x4*)(op + bj * HALF + n * 16) = r * alpha + acc[ai][bj][m][n]; } }
    }
};
template <class Epi, class Sched, bool ALIGN_EPI = false, bool SP2 = false>
__device__ __forceinline__ void gemm_phase(PG8_LAS unsigned char* lds, const Gemm g, const Sched& S, const Epi& E) {
    const int tid = threadIdx.x, wid = __builtin_amdgcn_readfirstlane(tid >> 6), lane = tid & 63, wr = wid >> 2, wc = wid & 3, fr = lane & 15, fq = lane >> 4;
    const int K = g.K, nt = K / BK;
    unsigned voffA[2], voffB[2];
#pragma unroll
    for (int i = 0; i < 2; ++i) { int R, C; stage_rc(tid * 16 + i * 8192, R, C); const int Rb = Epi::PERM ? ((R & ~31) + perm32(R & 31)) : R;
        voffA[i] = (unsigned)(R * g.lda + C) * 2u; voffB[i] = (unsigned)(Rb * K + C) * 2u; }
    const size_t kstep = (size_t)(BK * 2);
    const size_t hstepA = (size_t)HALF * g.lda * 2, hstepB = (size_t)HALF * K * 2;
    const size_t tstepA = 2 * hstepA, tstepB = 2 * hstepB;
    const unsigned ldsw = (unsigned)wid * 1024u;
    const int aoff = lds_byte(wr * 64 + fr, fq * 8), boff = lds_byte(wc * 32 + fr, fq * 8);
#define PG8_SA(b, h) (((b) * 2 + (h)) * HTB)
#define PG8_SB(b, h) ((4 + (b) * 2 + (h)) * HTB)
#define PG8_STAGE(bufoff, gbase, voff) do { _Pragma("unroll") for (int _i = 0; _i < 2; ++_i) \
        __builtin_amdgcn_global_load_lds((const unsigned*)((const char*)(gbase) + (voff)[_i]), (PG8_LAS unsigned*)(lds + (bufoff) + ldsw + _i * 8192), 16, 0, 0); } while (0)
#define PG8_LDA(dst, b, h) do { _Pragma("unroll") for (int m = 0; m < 4; ++m) _Pragma("unroll") for (int k = 0; k < 2; ++k) dst[m][k] = *(const PG8_LAS bf16x8*)(lds + PG8_SA(b, h) + aoff + m * 2048 + k * 1024); } while (0)
#define PG8_LDB(dst, b, h) do { _Pragma("unroll") for (int n = 0; n < 2; ++n) _Pragma("unroll") for (int k = 0; k < 2; ++k) dst[n][k] = *(const PG8_LAS bf16x8*)(lds + PG8_SB(b, h) + boff + n * 2048 + k * 1024); } while (0)
#define PG8_MMA(ai, bj, At, Bt) do { __builtin_amdgcn_s_setprio(1); _Pragma("unroll") for (int m = 0; m < 4; ++m) _Pragma("unroll") for (int n = 0; n < 2; ++n) _Pragma("unroll") for (int k = 0; k < 2; ++k) \
        acc[ai][bj][m][n] = __builtin_amdgcn_mfma_f32_16x16x32_bf16(Bt[n][k], At[m][k], acc[ai][bj][m][n], 0, 0, 0); __builtin_amdgcn_s_setprio(0); } while (0)
#define PG8_WAIT_V(n) asm volatile("s_waitcnt vmcnt(" #n ")" ::: "memory")
#define PG8_WAIT_L(n) asm volatile("s_waitcnt lgkmcnt(" #n ")" ::: "memory")
#define PG8_BAR __builtin_amdgcn_s_barrier()
#define PG8_SCHED __builtin_amdgcn_sched_barrier(0)
    Unit cur, nxt; int ui = 0;
    if (!S.next(0, cur)) return;
    f32x4 acc[2][2][4][2];
#pragma unroll
    for (int a = 0; a < 2; ++a)
#pragma unroll
        for (int b = 0; b < 2; ++b)
#pragma unroll
            for (int m = 0; m < 4; ++m)
#pragma unroll
                for (int n = 0; n < 2; ++n) acc[a][b][m][n] = (f32x4){0.f, 0.f, 0.f, 0.f};
    bf16x8 At[4][2], B0[2][2], B1[2][2];
    const char* cA = (const char*)g.A + (size_t)cur.pm * tstepA; const char* cB = (const char*)g.Bt + (size_t)cur.pn * tstepB;
    S.a_ready(cur);
    if constexpr (SP2) {
        PG8_STAGE(PG8_SB(0, 0), cB, voffB); PG8_STAGE(PG8_SB(0, 1), cB + hstepB, voffB); PG8_STAGE(PG8_SA(0, 0), cA, voffA); PG8_STAGE(PG8_SA(0, 1), cA + hstepA, voffA);
        if (wr == 1) PG8_BAR;
        PG8_WAIT_V(2); PG8_BAR;
        PG8_STAGE(PG8_SB(1, 0), cB + kstep, voffB); PG8_STAGE(PG8_SA(1, 0), cA + kstep, voffA); PG8_STAGE(PG8_SB(1, 1), cB + hstepB + kstep, voffB);
        PG8_WAIT_V(6); PG8_BAR;
    } else {
        PG8_STAGE(PG8_SB(0, 0), cB, voffB); PG8_STAGE(PG8_SA(0, 0), cA, voffA); PG8_STAGE(PG8_SB(0, 1), cB + hstepB, voffB); PG8_STAGE(PG8_SA(0, 1), cA + hstepA, voffA);
        if (wr == 1) PG8_BAR;
        PG8_WAIT_V(4); PG8_BAR;
        PG8_STAGE(PG8_SB(1, 0), cB + kstep, voffB); PG8_STAGE(PG8_SA(1, 0), cA + kstep, voffA); PG8_STAGE(PG8_SB(1, 1), cB + hstepB + kstep, voffB);
        PG8_WAIT_V(6); PG8_BAR;
    }
    for (;;) {
        const bool has_next = S.next(ui + 1, nxt);
        const char* nA = has_next ? (const char*)g.A + (size_t)nxt.pm * tstepA : cA; const char* nB = has_next ? (const char*)g.Bt + (size_t)nxt.pn * tstepB : cB;
        for (int t = 0; t < nt; t += 2) {
            const bool last = (t == nt - 2);
            const char* a1 = cA + (size_t)(t + 1) * kstep;
            const char* a2 = last ? nA : cA + (size_t)(t + 2) * kstep; const char* b2 = last ? nB : cB + (size_t)(t + 2) * kstep;
            const char* a3 = a2 + kstep; const char* b3 = b2 + kstep;
            if (last && has_next) S.a_ready(nxt);
            if constexpr (SP2) {
            PG8_LDB(B0, 0, 0); PG8_LDB(B1, 0, 1); PG8_SCHED; PG8_LDA(At, 0, 0); PG8_STAGE(PG8_SA(1, 1), a1 + hstepA, voffA);
            PG8_WAIT_V(8); PG8_WAIT_L(0); PG8_BAR; PG8_MMA(0, 0, At, B0); PG8_MMA(0, 1, At, B1); PG8_BAR; PG8_SCHED;
            PG8_LDA(At, 0, 1); PG8_STAGE(PG8_SB(0, 0), b2, voffB); PG8_STAGE(PG8_SB(0, 1), b2 + hstepB, voffB); PG8_STAGE(PG8_SA(0, 0), a2, voffA);
            PG8_WAIT_V(8); PG8_WAIT_L(0); PG8_BAR; PG8_MMA(1, 0, At, B0); PG8_MMA(1, 1, At, B1); PG8_BAR; PG8_SCHED;
            PG8_LDB(B0, 1, 0); PG8_LDB(B1, 1, 1); PG8_SCHED; PG8_LDA(At, 1, 0); PG8_STAGE(PG8_SA(0, 1), a2 + hstepA, voffA);
            PG8_WAIT_V(8); PG8_WAIT_L(0); PG8_BAR; PG8_MMA(0, 0, At, B0); PG8_MMA(0, 1, At, B1); PG8_BAR; PG8_SCHED;
            PG8_LDA(At, 1, 1); PG8_STAGE(PG8_SB(1, 0), b3, voffB); PG8_STAGE(PG8_SB(1, 1), b3 + hstepB, voffB); PG8_STAGE(PG8_SA(1, 0), a3, voffA);
            PG8_WAIT_V(8); PG8_WAIT_L(0); PG8_BAR; PG8_MMA(1, 0, At, B0); PG8_MMA(1, 1, At, B1); PG8_BAR; PG8_SCHED;
            } else {
            PG8_LDB(B0, 0, 0); PG8_SCHED; PG8_LDA(At, 0, 0); PG8_STAGE(PG8_SA(1, 1), a1 + hstepA, voffA);
            PG8_WAIT_L(8); PG8_BAR; PG8_WAIT_L(0); PG8_MMA(0, 0, At, B0); PG8_BAR; PG8_SCHED;
            PG8_LDB(B1, 0, 1); PG8_STAGE(PG8_SB(0, 0), b2, voffB);
            PG8_BAR; PG8_WAIT_L(0); PG8_MMA(0, 1, At, B1); PG8_BAR;
            PG8_LDA(At, 0, 1); PG8_STAGE(PG8_SA(0, 0), a2, voffA);
            PG8_BAR; PG8_WAIT_L(0); PG8_MMA(1, 0, At, B0); PG8_BAR; PG8_SCHED;
            PG8_STAGE(PG8_SB(0, 1), b2 + hstepB, voffB);
            PG8_WAIT_V(6); PG8_BAR; PG8_MMA(1, 1, At, B1); PG8_BAR;
            PG8_LDB(B0, 1, 0); PG8_SCHED; PG8_LDA(At, 1, 0); PG8_STAGE(PG8_SA(0, 1), a2 + hstepA, voffA);
            PG8_WAIT_L(8); PG8_BAR; PG8_WAIT_L(0); PG8_MMA(0, 0, At, B0); PG8_BAR; PG8_SCHED;
            PG8_LDB(B1, 1, 1); PG8_STAGE(PG8_SB(1, 0), b3, voffB);
            PG8_BAR; PG8_WAIT_L(0); PG8_MMA(0, 1, At, B1); PG8_BAR;
            PG8_LDA(At, 1, 1); PG8_STAGE(PG8_SA(1, 0), a3, voffA);
            PG8_BAR; PG8_WAIT_L(0); PG8_MMA(1, 0, At, B0); PG8_BAR; PG8_SCHED;
            PG8_STAGE(PG8_SB(1, 1), b3 + hstepB, voffB);
            PG8_WAIT_V(6); PG8_BAR; PG8_MMA(1, 1, At, B1); PG8_BAR;
            }
        }
        if constexpr (ALIGN_EPI) { if (wr == 0) PG8_BAR; }
        if constexpr (!Epi::AFTER_DRAIN) { E(acc, cur, wr, wc, fr, fq); S.done(cur); }
        if (!has_next) break;
#pragma unroll
        for (int a = 0; a < 2; ++a)
#pragma unroll
            for (int b = 0; b < 2; ++b)
#pragma unroll
                for (int m = 0; m < 4; ++m)
#pragma unroll
                    for (int n = 0; n < 2; ++n) acc[a][b][m][n] = (f32x4){0.f, 0.f, 0.f, 0.f};
        cur = nxt; cA = nA; cB = nB; ++ui;
        if constexpr (ALIGN_EPI) { if (wr == 1) PG8_BAR; }
    }
    PG8_WAIT_V(0);
    if constexpr (!ALIGN_EPI) { if (wr == 0) PG8_BAR; }
    PG8_BAR;
    if constexpr (Epi::AFTER_DRAIN) { E.fused(acc, cur, wr, wc, fr, fq, lds, wid, lane); S.done(cur); }
#undef PG8_SA
#undef PG8_SB
#undef PG8_STAGE
#undef PG8_LDA
#undef PG8_LDB
#undef PG8_MMA
#undef PG8_WAIT_V
#undef PG8_WAIT_L
#undef PG8_BAR
#undef PG8_SCHED
}
}

#define LAS __attribute__((address_space(3)))
typedef LAS unsigned char* ldsp;
using pg8::bf16_t; using pg8::bf16x8; using pg8::f32x4; using pg8::u32x4; using pg8::cvt_pk_bf16;
typedef unsigned u32x2 __attribute__((ext_vector_type(2)));

constexpr int T = 18432, TP = 16384, DM = 1024;
constexpr float DN_ALPHA = 1.41421356237f;
constexpr float LN_EPS = 1e-5f;
constexpr size_t O_YP = 0, O_YS = 16777216, O_SSMP = 18874368, O_CONVP = 20971520, O_SSMS = 21069824, O_CONVS = 29458432, O_VROWS = 29851648;
constexpr size_t WS_XB = 0, WS_BIG = 37748736, WS_WIN = 188743680, WS_WOUT = 201392128, WS_W1 = 205586432, WS_W2 = 222363648, WS_CMWIN = 239140864, WS_CMWOUT = 247529472, WS_DT = 251723776, WS_END = 254083072;
constexpr int LDS_BYTES = 149504;
constexpr int NPHASE = 17;

struct Params { const float* in[25]; float* out; unsigned char* ws; int ph_lo, ph_hi; };

__device__ __forceinline__ float bf_lo(unsigned w) { return __uint_as_float(w << 16); }
__device__ __forceinline__ float bf_hi(unsigned w) { return __uint_as_float(w & 0xffff0000u); }
__device__ __forceinline__ unsigned short f2bf(float f) { unsigned u = __float_as_uint(f); u += 0x7FFFu + ((u >> 16) & 1u); return (unsigned short)(u >> 16); }
__device__ __forceinline__ float silu_f(float x) { return x / (1.0f + __expf(-x)); }
__device__ __forceinline__ float wave_sum(float v) {
#pragma unroll
    for (int o = 32; o >= 1; o >>= 1) v += __shfl_xor(v, o);
    return v;
}
__device__ __forceinline__ f32x4 mfma16(bf16x8 a, bf16x8 b, f32x4 c) { return __builtin_amdgcn_mfma_f32_16x16x32_bf16(a, b, c, 0, 0, 0); }

__device__ __forceinline__ void transpose_cvt(const float* __restrict__ W, int K, int N, bf16_t* __restrict__ WT, ldsp lds) {
    LAS float* tile = (LAS float*)lds;
    const int tid = threadIdx.x; const int ntn = (N + 63) / 64, ntiles = (K / 64) * ntn;
    for (int t = blockIdx.x; t < ntiles; t += gridDim.x) {
        const int k0 = (t / ntn) * 64, n0 = (t % ntn) * 64;
#pragma unroll
        for (int i = 0; i < 8; ++i) { const int k = (tid >> 6) + 8 * i, n = tid & 63; tile[k * 65 + n] = (n0 + n < N) ? W[(size_t)(k0 + k) * N + n0 + n] : 0.f; }
        __syncthreads();
#pragma unroll
        for (int i = 0; i < 4; ++i) { const int kp = 2 * (tid & 31), nn = (tid >> 5) + 16 * i;
            if (n0 + nn < N) *(unsigned*)(WT + (size_t)(n0 + nn) * K + k0 + kp) = cvt_pk_bf16(tile[kp * 65 + nn], tile[(kp + 1) * 65 + nn]); }
        __syncthreads();
    }
}
__device__ __forceinline__ void phase_prep(const Params& p, ldsp lds) {
    unsigned char* ws = p.ws;
    transpose_cvt(p.in[4], 1024, 6176, (bf16_t*)(ws + WS_WIN), lds);
    transpose_cvt(p.in[11], 2048, 1024, (bf16_t*)(ws + WS_WOUT), lds);
    transpose_cvt(p.in[19], 1024, 4096, (bf16_t*)(ws + WS_W1), lds);
    transpose_cvt(p.in[19] + (size_t)1024 * 4096, 1024, 4096, (bf16_t*)(ws + WS_W1) + (size_t)4096 * 1024, lds);
    transpose_cvt(p.in[20], 4096, 1024, (bf16_t*)(ws + WS_W2), lds);
    transpose_cvt(p.in[20] + (size_t)4096 * 1024, 4096, 1024, (bf16_t*)(ws + WS_W2) + (size_t)4096 * 1024, lds);
    transpose_cvt(p.in[12], 1024, 4096, (bf16_t*)(ws + WS_CMWIN), lds);
    transpose_cvt(p.in[18], 2048, 1024, (bf16_t*)(ws + WS_CMWOUT), lds);
    const f32x4* xp = (const f32x4*)p.in[0]; const f32x4* xs = (const f32x4*)p.in[1]; u32x2* xb = (u32x2*)(ws + WS_XB);
    const int n4p = TP * DM / 4, n4 = T * DM / 4;
    for (int i = blockIdx.x * 512 + threadIdx.x; i < n4; i += gridDim.x * 512) { const f32x4 v = (i < n4p) ? xp[i] : xs[i - n4p]; u32x2 w; w.x = cvt_pk_bf16(v[0], v[1]); w.y = cvt_pk_bf16(v[2], v[3]); xb[i] = w; }
}

__device__ __forceinline__ void phase_dt(const Params& p) {
    const int tid = threadIdx.x, wid = tid >> 6, lane = tid & 63;
    const bf16_t* XB = (const bf16_t*)(p.ws + WS_XB); const bf16_t* WT = (const bf16_t*)(p.ws + WS_WIN) + (size_t)6144 * 1024; float* DT = (float*)(p.ws + WS_DT);
    const float* bias = p.in[7];
    for (int tile = blockIdx.x * 8 + wid; tile < T / 16; tile += gridDim.x * 8) {
        f32x4 a0 = {0.f, 0.f, 0.f, 0.f}, a1 = {0.f, 0.f, 0.f, 0.f};
        const bf16_t* ap = XB + (size_t)(tile * 16 + (lane & 15)) * 1024 + 8 * (lane >> 4);
        const bf16_t* bp0 = WT + (size_t)(lane & 15) * 1024 + 8 * (lane >> 4); const bf16_t* bp1 = bp0 + 16 * 1024;
#pragma unroll 4
        for (int kk = 0; kk < 32; ++kk) { const bf16x8 a = *(const bf16x8*)(ap + kk * 32), b0 = *(const bf16x8*)(bp0 + kk * 32), b1 = *(const bf16x8*)(bp1 + kk * 32); a0 = mfma16(a, b0, a0); a1 = mfma16(a, b1, a1); }
        const int hd = lane & 15; const float bb0 = bias[hd], bb1 = bias[16 + hd];
#pragma unroll
        for (int r = 0; r < 4; ++r) { const int tok = tile * 16 + (lane >> 4) * 4 + r; const float x0 = a0[r] + bb0, x1 = a1[r] + bb1;
            DT[(size_t)tok * 32 + hd] = x0 > 20.f ? x0 : log1pf(__expf(x0)); DT[(size_t)tok * 32 + 16 + hd] = x1 > 20.f ? x1 : log1pf(__expf(x1)); }
    }
}

constexpr int L_RAW = 0, L_MS = 0, L_YF = 9216, L_CS = 44032, L_BS = 61440, L_BT = 78848, L_XDT = 97280, L_XW = 106496, L_XS = 115712, L_HB = 124928, L_CW = 142336, L_DTS = 148736, L_ACS = 148992;
constexpr int RAW_ST = 656, ST128 = 272, ST64 = 144;
__device__ __forceinline__ int scan_chan(int j0, int h, int g) { return j0 < 64 ? h * 64 + j0 : (j0 < 192 ? 2048 + g * 128 + (j0 - 64) : 3072 + g * 128 + (j0 - 192)); }
__device__ __forceinline__ void conv8(ldsp lds, int t, int j0, float (&o)[8]) {
    const LAS float* cw = (const LAS float*)(lds + L_CW);
#pragma unroll
    for (int e = 0; e < 8; ++e) o[e] = cw[4 * 320 + j0 + e];
#pragma unroll
    for (int k = 0; k < 4; ++k) { const u32x4 r = *(const LAS u32x4*)(lds + L_RAW + (t + k) * RAW_ST + j0 * 2);
        const float x[8] = {bf_lo(r.x), bf_hi(r.x), bf_lo(r.y), bf_hi(r.y), bf_lo(r.z), bf_hi(r.z), bf_lo(r.w), bf_hi(r.w)};
#pragma unroll
        for (int e = 0; e < 8; ++e) o[e] += cw[k * 320 + j0 + e] * x[e]; }
#pragma unroll
    for (int e = 0; e < 8; ++e) o[e] = silu_f(o[e]);
}
__device__ __forceinline__ void phase_scan(const Params& p, ldsp lds) {
    const int tid = threadIdx.x, wid = tid >> 6, lane = tid & 63, fr = lane & 15, fq = lane >> 4;
    const bf16_t* XBC = (const bf16_t*)(p.ws + WS_BIG); bf16_t* Z = (bf16_t*)p.out; const float* DT = (const float*)(p.ws + WS_DT);
    LAS float* cw = (LAS float*)(lds + L_CW); LAS float* dts = (LAS float*)(lds + L_DTS); LAS float* acs = (LAS float*)(lds + L_ACS);
    for (int chain = blockIdx.x; chain < 1280; chain += gridDim.x) {
        int b, h, nsteps, row0; const float* h0 = nullptr; const float* cprev = nullptr; float* hout;
        if (chain < 256) { b = chain >> 5; h = chain & 31; nsteps = 32; row0 = b * 2048; hout = p.out + O_SSMP + (size_t)(b * 32 + h) * 8192; }
        else { const int i = chain - 256; b = i >> 5; h = i & 31; nsteps = 1; row0 = TP + b * 64; h0 = p.in[2] + (size_t)(b * 32 + h) * 8192; cprev = p.in[3] + (size_t)b * 3 * 4096; hout = p.out + O_SSMS + (size_t)(b * 32 + h) * 8192; }
        const int g = h >> 2; const float A_h = -__expf(p.in[8][h]), D_h = p.in[9][h];
        for (int idx = tid; idx < 1600; idx += 512) { const int k = idx / 320, j = idx % 320, ch = scan_chan(j, h, g); cw[idx] = k < 4 ? p.in[5][k * 4096 + ch] : p.in[6][ch]; }
        const int hp = wid >> 1;
        f32x4 hacc[4];
#pragma unroll
        for (int q = 0; q < 4; ++q)
#pragma unroll
            for (int r = 0; r < 4; ++r) { const int pp = hp * 16 + 4 * fq + r, n = (4 * (wid & 1) + q) * 16 + fr; const float v = h0 ? h0[pp * 128 + n] : 0.f; hacc[q][r] = v;
                *(LAS unsigned short*)(lds + L_HB + pp * ST128 + n * 2) = f2bf(v); }
        __syncthreads();
        for (int step = 0; step < nsteps; ++step) {
            const int R = row0 + step * 64;
            for (int idx = tid; idx < 67 * 40; idx += 512) { const int ri = idx / 40, j0 = (idx % 40) * 8, ch = scan_chan(j0, h, g);
                u32x4 val = {0u, 0u, 0u, 0u};
                if (ri >= 3 || step > 0) val = *(const u32x4*)(XBC + (size_t)(R - 3 + ri) * 4096 + ch);
                else if (cprev) { const f32x4 c0 = *(const f32x4*)(cprev + ri * 4096 + ch), c1 = *(const f32x4*)(cprev + ri * 4096 + ch + 4);
                    val.x = cvt_pk_bf16(c0[0], c0[1]); val.y = cvt_pk_bf16(c0[2], c0[3]); val.z = cvt_pk_bf16(c1[0], c1[1]); val.w = cvt_pk_bf16(c1[2], c1[3]); }
                *(LAS u32x4*)(lds + L_RAW + ri * RAW_ST + j0 * 2) = val; }
            const int et = tid >> 3, ec = (tid & 7) * 8;
            const u32x4 zraw = *(const u32x4*)(Z + (size_t)(R + et) * 2048 + h * 64 + ec);
            if (wid == 0) { const float dtv = DT[(size_t)(R + lane) * 32 + h]; float v = dtv * A_h;
#pragma unroll
                for (int d = 1; d < 64; d <<= 1) { const float n = __shfl_up(v, d); if (lane >= d) v += n; }
                dts[lane] = dtv; acs[lane] = v; }
            __syncthreads();
            const float a_last = acs[63];
            if (step == nsteps - 1) {
                float* cdst = (chain < 256 ? p.out + O_CONVP : p.out + O_CONVS) + (size_t)b * 3 * 4096;
                for (int idx = tid; idx < 960; idx += 512) { const int k = idx / 320, j = idx % 320;
                    if (j < 64 || (h & 3) == 0) cdst[k * 4096 + scan_chan(j, h, g)] = __uint_as_float(((unsigned)*(const LAS unsigned short*)(lds + L_RAW + (64 + k) * RAW_ST + j * 2)) << 16); } }
            { float o[8]; conv8(lds, et, ec, o); const float dtv = dts[et], wv = dtv * __expf(a_last - acs[et]);
                u32x4 w; w.x = cvt_pk_bf16(o[0], o[1]); w.y = cvt_pk_bf16(o[2], o[3]); w.z = cvt_pk_bf16(o[4], o[5]); w.w = cvt_pk_bf16(o[6], o[7]);
                *(LAS u32x4*)(lds + L_XS + et * ST64 + ec * 2) = w;
#pragma unroll
                for (int e = 0; e < 8; ++e) { *(LAS unsigned short*)(lds + L_XDT + (ec + e) * ST64 + et * 2) = f2bf(o[e] * dtv); *(LAS unsigned short*)(lds + L_XW + (ec + e) * ST64 + et * 2) = f2bf(o[e] * wv); } }
#pragma unroll
            for (int i = 0; i < 2; ++i) { const int item = tid + 512 * i, t = item >> 4, n0 = (item & 15) * 8; float o[8];
                conv8(lds, t, 64 + n0, o);
                { u32x4 w; w.x = cvt_pk_bf16(o[0], o[1]); w.y = cvt_pk_bf16(o[2], o[3]); w.z = cvt_pk_bf16(o[4], o[5]); w.w = cvt_pk_bf16(o[6], o[7]); *(LAS u32x4*)(lds + L_BS + t * ST128 + n0 * 2) = w; }
#pragma unroll
                for (int e = 0; e < 8; ++e) *(LAS unsigned short*)(lds + L_BT + (n0 + e) * ST64 + t * 2) = f2bf(o[e]);
                conv8(lds, t, 192 + n0, o);
                { u32x4 w; w.x = cvt_pk_bf16(o[0], o[1]); w.y = cvt_pk_bf16(o[2], o[3]); w.z = cvt_pk_bf16(o[4], o[5]); w.w = cvt_pk_bf16(o[6], o[7]); *(LAS u32x4*)(lds + L_CS + t * ST128 + n0 * 2) = w; } }
            __syncthreads();
            const int ti = wid >> 1;
            f32x4 yacc[2];
            { bf16x8 af[4];
#pragma unroll
                for (int kk = 0; kk < 4; ++kk) af[kk] = *(const LAS bf16x8*)(lds + L_CS + (ti * 16 + fr) * ST128 + (kk * 32 + 8 * fq) * 2);
                float act[4];
#pragma unroll
                for (int r = 0; r < 4; ++r) act[r] = acs[ti * 16 + 4 * fq + r];
#pragma unroll
                for (int q = 0; q < 2; ++q) { const int si = 2 * (wid & 1) + q; f32x4 cb = {0.f, 0.f, 0.f, 0.f};
#pragma unroll
                    for (int kk = 0; kk < 4; ++kk) cb = mfma16(af[kk], *(const LAS bf16x8*)(lds + L_BS + (si * 16 + fr) * ST128 + (kk * 32 + 8 * fq) * 2), cb);
                    const int s = si * 16 + fr; const float as = acs[s];
#pragma unroll
                    for (int r = 0; r < 4; ++r) { const int t = ti * 16 + 4 * fq + r; const float mv = (s <= t) ? cb[r] * __expf(act[r] - as) : 0.f; *(LAS unsigned short*)(lds + L_MS + t * ST64 + s * 2) = f2bf(mv); } }
#pragma unroll
                for (int q = 0; q < 2; ++q) { const int pi = 2 * (wid & 1) + q; f32x4 y = {0.f, 0.f, 0.f, 0.f};
#pragma unroll
                    for (int kk = 0; kk < 4; ++kk) y = mfma16(af[kk], *(const LAS bf16x8*)(lds + L_HB + (pi * 16 + fr) * ST128 + (kk * 32 + 8 * fq) * 2), y);
#pragma unroll
                    for (int r = 0; r < 4; ++r) y[r] *= __expf(act[r]);
                    yacc[q] = y; } }
            __syncthreads();
            {
#pragma unroll
                for (int q = 0; q < 2; ++q) { const int pi = 2 * (wid & 1) + q;
#pragma unroll
                    for (int kk = 0; kk < 2; ++kk) yacc[q] = mfma16(*(const LAS bf16x8*)(lds + L_MS + (ti * 16 + fr) * ST64 + (kk * 32 + 8 * fq) * 2), *(const LAS bf16x8*)(lds + L_XDT + (pi * 16 + fr) * ST64 + (kk * 32 + 8 * fq) * 2), yacc[q]);
#pragma unroll
                    for (int r = 0; r < 4; ++r) *(LAS float*)(lds + L_YF + (ti * 16 + 4 * fq + r) * ST128 + (pi * 16 + fr) * 4) = yacc[q][r]; }
                const float ea = __expf(a_last);
                bf16x8 xa[2];
#pragma unroll
                for (int kk = 0; kk < 2; ++kk) xa[kk] = *(const LAS bf16x8*)(lds + L_XW + (hp * 16 + fr) * ST64 + (kk * 32 + 8 * fq) * 2);
#pragma unroll
                for (int q = 0; q < 4; ++q) { const int ni = 4 * (wid & 1) + q; f32x4 hv = hacc[q] * ea;
#pragma unroll
                    for (int kk = 0; kk < 2; ++kk) hv = mfma16(xa[kk], *(const LAS bf16x8*)(lds + L_BT + (ni * 16 + fr) * ST64 + (kk * 32 + 8 * fq) * 2), hv);
                    hacc[q] = hv;
#pragma unroll
                    for (int r = 0; r < 4; ++r) *(LAS unsigned short*)(lds + L_HB + (hp * 16 + 4 * fq + r) * ST128 + (ni * 16 + fr) * 2) = f2bf(hv[r]); } }
            __syncthreads();
            { const u32x4 xr = *(const LAS u32x4*)(lds + L_XS + et * ST64 + ec * 2);
                const f32x4 y0 = *(const LAS f32x4*)(lds + L_YF + et * ST128 + ec * 4), y1 = *(const LAS f32x4*)(lds + L_YF + et * ST128 + ec * 4 + 16);
                const float xs[8] = {bf_lo(xr.x), bf_hi(xr.x), bf_lo(xr.y), bf_hi(xr.y), bf_lo(xr.z), bf_hi(xr.z), bf_lo(xr.w), bf_hi(xr.w)};
                const float zz[8] = {bf_lo(zraw.x), bf_hi(zraw.x), bf_lo(zraw.y), bf_hi(zraw.y), bf_lo(zraw.z), bf_hi(zraw.z), bf_lo(zraw.w), bf_hi(zraw.w)};
                float gg[8];
#pragma unroll
                for (int e = 0; e < 8; ++e) { const float yv = (e < 4 ? y0[e & 3] : y1[e & 3]) + D_h * xs[e]; gg[e] = yv * silu_f(zz[e]); }
                u32x4 w; w.x = cvt_pk_bf16(gg[0], gg[1]); w.y = cvt_pk_bf16(gg[2], gg[3]); w.z = cvt_pk_bf16(gg[4], gg[5]); w.w = cvt_pk_bf16(gg[6], gg[7]);
                *(u32x4*)(Z + (size_t)(R + et) * 2048 + h * 64 + ec) = w; }
            __syncthreads();
        }
#pragma unroll
        for (int q = 0; q < 4; ++q)
#pragma unroll
            for (int r = 0; r < 4; ++r) hout[(hp * 16 + 4 * fq + r) * 128 + (4 * (wid & 1) + q) * 16 + fr] = hacc[q][r];
    }
}

__device__ __forceinline__ void phase_gnorm(const Params& p) {
    const int wid = threadIdx.x >> 6, lane = threadIdx.x & 63; bf16_t* Z = (bf16_t*)p.out; const float* nw = p.in[10];
    for (int row = blockIdx.x * 8 + wid; row < T; row += gridDim.x * 8) {
        bf16_t* zr = Z + (size_t)row * 2048 + 8 * lane;
        u32x4 raw[4];
#pragma unroll
        for (int j = 0; j < 4; ++j) raw[j] = *(const u32x4*)(zr + 512 * j);
#pragma unroll
        for (int j = 0; j < 4; ++j) { const float v[8] = {bf_lo(raw[j].x), bf_hi(raw[j].x), bf_lo(raw[j].y), bf_hi(raw[j].y), bf_lo(raw[j].z), bf_hi(raw[j].z), bf_lo(raw[j].w), bf_hi(raw[j].w)};
            float ss = 0.f;
#pragma unroll
            for (int e = 0; e < 8; ++e) ss += v[e] * v[e];
#pragma unroll
            for (int o = 16; o >= 1; o >>= 1) ss += __shfl_xor(ss, o);
            const float sc = rsqrtf(ss * (1.0f / 256.0f) + LN_EPS);
            const f32x4 w0 = *(const f32x4*)(nw + 512 * j + 8 * lane), w1 = *(const f32x4*)(nw + 512 * j + 8 * lane + 4);
            u32x4 w; w.x = cvt_pk_bf16(v[0] * sc * w0[0], v[1] * sc * w0[1]); w.y = cvt_pk_bf16(v[2] * sc * w0[2], v[3] * sc * w0[3]); w.z = cvt_pk_bf16(v[4] * sc * w1[0], v[5] * sc * w1[1]); w.w = cvt_pk_bf16(v[6] * sc * w1[2], v[7] * sc * w1[3]);
            *(u32x4*)(zr + 512 * j) = w; }
    }
}

__device__ __forceinline__ void phase_ln(const float* src, float* dstf, bf16_t* dstb, const float* gam, const float* bet) {
    const int wid = threadIdx.x >> 6, lane = threadIdx.x & 63;
    f32x4 gv[4], bv[4];
#pragma unroll
    for (int j = 0; j < 4; ++j) { gv[j] = *(const f32x4*)(gam + 256 * j + 4 * lane); bv[j] = *(const f32x4*)(bet + 256 * j + 4 * lane); }
    for (int row = blockIdx.x * 8 + wid; row < T; row += gridDim.x * 8) {
        const float* s = src + (size_t)row * 1024 + 4 * lane; f32x4 v[4]; float sum = 0.f;
#pragma unroll
        for (int j = 0; j < 4; ++j) { v[j] = *(const f32x4*)(s + 256 * j); sum += (v[j][0] + v[j][1]) + (v[j][2] + v[j][3]); }
        const float mean = wave_sum(sum) * (1.0f / 1024.0f); float q = 0.f;
#pragma unroll
        for (int j = 0; j < 4; ++j) { const f32x4 d = v[j] - mean; q += (d[0] * d[0] + d[1] * d[1]) + (d[2] * d[2] + d[3] * d[3]); }
        const float rstd = rsqrtf(wave_sum(q) * (1.0f / 1024.0f) + LN_EPS);
#pragma unroll
        for (int j = 0; j < 4; ++j) { const f32x4 o = (v[j] - mean) * rstd * gv[j] + bv[j];
            *(f32x4*)(dstf + (size_t)row * 1024 + 4 * lane + 256 * j) = o;
            if (dstb) { u32x2 w; w.x = cvt_pk_bf16(o[0], o[1]); w.y = cvt_pk_bf16(o[2], o[3]); *(u32x2*)(dstb + (size_t)row * 1024 + 4 * lane + 256 * j) = w; } }
    }
}

__device__ __forceinline__ void phase_lnv(const Params& p) {
    const int wid = threadIdx.x >> 6, lane = threadIdx.x & 63; bf16_t* BIG = (bf16_t*)(p.ws + WS_BIG); const float* gam = p.in[14]; const float* bet = p.in[15]; float* vrows = p.out + O_VROWS;
    for (int row = blockIdx.x * 8 + wid; row < T; row += gridDim.x * 8) {
        bf16_t* vr = BIG + (size_t)row * 4096 + 2048 + 8 * lane; float v[4][8]; float sum = 0.f;
#pragma unroll
        for (int j = 0; j < 4; ++j) { const u32x4 r = *(const u32x4*)(vr + 512 * j);
            v[j][0] = bf_lo(r.x); v[j][1] = bf_hi(r.x); v[j][2] = bf_lo(r.y); v[j][3] = bf_hi(r.y); v[j][4] = bf_lo(r.z); v[j][5] = bf_hi(r.z); v[j][6] = bf_lo(r.w); v[j][7] = bf_hi(r.w);
#pragma unroll
            for (int e = 0; e < 8; ++e) sum += v[j][e]; }
        const float mean = wave_sum(sum) * (1.0f / 2048.0f); float q = 0.f;
#pragma unroll
        for (int j = 0; j < 4; ++j)
#pragma unroll
            for (int e = 0; e < 8; ++e) { const float d = v[j][e] - mean; q += d * d; }
        const float rstd = rsqrtf(wave_sum(q) * (1.0f / 2048.0f) + LN_EPS);
#pragma unroll
        for (int j = 0; j < 4; ++j) { const int c = 512 * j + 8 * lane;
            const f32x4 g0 = *(const f32x4*)(gam + c), g1 = *(const f32x4*)(gam + c + 4), b0 = *(const f32x4*)(bet + c), b1 = *(const f32x4*)(bet + c + 4);
            f32x4 o0, o1;
#pragma unroll
            for (int e = 0; e < 4; ++e) { o0[e] = (v[j][e] - mean) * rstd * g0[e] + b0[e]; o1[e] = (v[j][4 + e] - mean) * rstd * g1[e] + b1[e]; }
            u32x4 w; w.x = cvt_pk_bf16(o0[0], o0[1]); w.y = cvt_pk_bf16(o0[2], o0[3]); w.z = cvt_pk_bf16(o1[0], o1[1]); w.w = cvt_pk_bf16(o1[2], o1[3]);
            *(u32x4*)(vr + 512 * j) = w;
            if (row >= TP) { float* d = vrows + (size_t)(row - TP) * 2048 + c; *(f32x4*)d = o0; *(f32x4*)(d + 4) = o1; } }
    }
}

constexpr int SP_VT = 0, SP_WS = 69632, SP_SO = 0, SP_VST = 272, SP_SOST = 528;
__device__ __forceinline__ void phase_spatial(const Params& p, ldsp lds) {
    const int tid = threadIdx.x, wid = tid >> 6, lane = tid & 63, fr = lane & 15, fq = lane >> 4;
    bf16_t* BIG = (bf16_t*)(p.ws + WS_BIG); const float* wsp = p.in[16]; const float* bsp = p.in[17];
    for (int unit = blockIdx.x; unit < 1280; unit += gridDim.x) {
        int R, L, g;
        if (unit < 1024) { g = unit & 7; R = (unit >> 3) * 128; L = 128; } else { const int i = unit - 1024; g = i & 7; R = TP + (i >> 3) * 64; L = 64; }
        for (int idx = tid; idx < L * 32; idx += 512) { const int s = idx >> 5, c8 = (idx & 31) * 8; const u32x4 r = *(const u32x4*)(BIG + (size_t)(R + s) * 4096 + 2048 + g * 256 + c8);
            const unsigned wv[4] = {r.x, r.y, r.z, r.w};
#pragma unroll
            for (int e = 0; e < 4; ++e) { *(LAS unsigned short*)(lds + SP_VT + (c8 + 2 * e) * SP_VST + s * 2) = (unsigned short)(wv[e] & 0xffffu); *(LAS unsigned short*)(lds + SP_VT + (c8 + 2 * e + 1) * SP_VST + s * 2) = (unsigned short)(wv[e] >> 16); } }
        for (int idx = tid; idx < L * (L / 4); idx += 512) { const int t = idx / (L / 4), s0 = (idx % (L / 4)) * 4; const f32x4 w = *(const f32x4*)(wsp + (size_t)(g * 128 + t) * 128 + s0);
            u32x2 o; o.x = cvt_pk_bf16(s0 <= t ? w[0] : 0.f, s0 + 1 <= t ? w[1] : 0.f); o.y = cvt_pk_bf16(s0 + 2 <= t ? w[2] : 0.f, s0 + 3 <= t ? w[3] : 0.f);
            *(LAS u32x2*)(lds + SP_WS + t * SP_VST + s0 * 2) = o; }
        __syncthreads();
        const int nT = L / 16, nK = L / 32;
        f32x4 acc[8][2];
#pragma unroll
        for (int ti = 0; ti < 8; ++ti) { acc[ti][0] = (f32x4){0.f, 0.f, 0.f, 0.f}; acc[ti][1] = (f32x4){0.f, 0.f, 0.f, 0.f}; }
#pragma unroll
        for (int kk = 0; kk < 4; ++kk) if (kk < nK) {
            const bf16x8 b0 = *(const LAS bf16x8*)(lds + SP_VT + (wid * 32 + fr) * SP_VST + (kk * 32 + 8 * fq) * 2), b1 = *(const LAS bf16x8*)(lds + SP_VT + (wid * 32 + 16 + fr) * SP_VST + (kk * 32 + 8 * fq) * 2);
#pragma unroll
            for (int ti = 0; ti < 8; ++ti) if (ti < nT && 32 * kk <= 16 * ti + 15) { const bf16x8 a = *(const LAS bf16x8*)(lds + SP_WS + (ti * 16 + fr) * SP_VST + (kk * 32 + 8 * fq) * 2);
                acc[ti][0] = mfma16(a, b0, acc[ti][0]); acc[ti][1] = mfma16(a, b1, acc[ti][1]); } }
        __syncthreads();
#pragma unroll
        for (int ti = 0; ti < 8; ++ti) if (ti < nT) {
#pragma unroll
            for (int r = 0; r < 4; ++r) { const int t = ti * 16 + 4 * fq + r; const float bb = bsp[g * 128 + t];
                *(LAS unsigned short*)(lds + SP_SO + t * SP_SOST + (wid * 32 + fr) * 2) = f2bf(acc[ti][0][r] + bb); *(LAS unsigned short*)(lds + SP_SO + t * SP_SOST + (wid * 32 + 16 + fr) * 2) = f2bf(acc[ti][1][r] + bb); } }
        __syncthreads();
        for (int idx = tid; idx < L * 32; idx += 512) { const int t = idx >> 5, c8 = (idx & 31) * 8; bf16_t* up = BIG + (size_t)(R + t) * 4096 + g * 256 + c8;
            const u32x4 uu = *(const u32x4*)up; const u32x4 ss = *(const LAS u32x4*)(lds + SP_SO + t * SP_SOST + c8 * 2);
            u32x4 w; w.x = cvt_pk_bf16(bf_lo(uu.x) * bf_lo(ss.x), bf_hi(uu.x) * bf_hi(ss.x)); w.y = cvt_pk_bf16(bf_lo(uu.y) * bf_lo(ss.y), bf_hi(uu.y) * bf_hi(ss.y));
            w.z = cvt_pk_bf16(bf_lo(uu.z) * bf_lo(ss.z), bf_hi(uu.z) * bf_hi(ss.z)); w.w = cvt_pk_bf16(bf_lo(uu.w) * bf_lo(ss.w), bf_hi(uu.w) * bf_hi(ss.w));
            *(u32x4*)up = w; }
        __syncthreads();
    }
}

__global__ void __launch_bounds__(512, 2) fwd_kernel(Params p) {
    extern __shared__ __attribute__((aligned(16))) unsigned char smem[];
    ldsp lds = (ldsp)smem;
    cg::grid_group grid = cg::this_grid();
    unsigned char* ws = p.ws; const int G = gridDim.x, bid = blockIdx.x;
    bf16_t* XB = (bf16_t*)(ws + WS_XB); bf16_t* BIG = (bf16_t*)(ws + WS_BIG); float* Y = p.out; bf16_t* Zb = (bf16_t*)p.out;
#define RUN(k) (((PHMASK >> (k)) & 1) && p.ph_lo <= (k) && (k) <= p.ph_hi)
#define SEAM(k) do { if (p.ph_lo <= (k) && (k) < p.ph_hi) grid.sync(); } while (0)
    if (RUN(0)) phase_prep(p, lds);
    SEAM(0);
    if (RUN(1)) { pg8::Gemm g{XB, (const bf16_t*)(ws + WS_WIN), T, 6144, 1024, 1024}; pg8::StaticOrder S; S.init(T, 6144, G, bid);
        pg8::EpiG1 E{Zb, BIG};
        pg8::gemm_phase<pg8::EpiG1, pg8::StaticOrder, true, true>(lds, g, S, E);
        phase_dt(p); }
    SEAM(1);
    if (RUN(2)) phase_scan(p, lds);
    SEAM(2);
    if (RUN(3)) phase_gnorm(p);
    SEAM(3);
    if (RUN(4)) { pg8::Gemm g{Zb, (const bf16_t*)(ws + WS_WOUT), T, 1024, 2048, 2048}; pg8::StaticOrder S; S.init(T, 1024, G, bid);
        pg8::EpiRes E{p.in[0], p.in[1], (float*)(ws + WS_BIG), DN_ALPHA};
        pg8::gemm_phase<pg8::EpiRes, pg8::StaticOrder, true, true>(lds, g, S, E); }
    SEAM(4);
    if (RUN(5)) phase_ln((const float*)(ws + WS_BIG), Y, XB, p.in[21], p.in[22]);
    SEAM(5);
    if (RUN(6)) { pg8::Gemm g{XB, (const bf16_t*)(ws + WS_W1), T, 4096, 1024, 1024}; pg8::StaticOrder S; S.init(T, 4096, G, bid);
        pg8::EpiAct<1> E{BIG, 4096, nullptr};
        pg8::gemm_phase<pg8::EpiAct<1>, pg8::StaticOrder, true, true>(lds, g, S, E); }
    SEAM(6);
    if (RUN(7)) { pg8::Gemm g{BIG, (const bf16_t*)(ws + WS_W2), T, 1024, 4096, 4096}; pg8::StaticOrder S; S.init(T, 1024, G, bid);
        pg8::EpiRes E{Y, Y + (size_t)TP * 1024, Y, DN_ALPHA};
        pg8::gemm_phase<pg8::EpiRes, pg8::StaticOrder, true, true>(lds, g, S, E); }
    SEAM(7);
    if (RUN(8)) phase_ln(Y, Y, XB, p.in[23], p.in[24]);
    SEAM(8);
    if (RUN(9)) { pg8::Gemm g{XB, (const bf16_t*)(ws + WS_CMWIN), T, 4096, 1024, 1024}; pg8::StaticOrder S; S.init(T, 4096, G, bid);
        pg8::EpiAct<2> E{BIG, 4096, p.in[13]};
        pg8::gemm_phase<pg8::EpiAct<2>, pg8::StaticOrder, true, true>(lds, g, S, E); }
    SEAM(9);
    if (RUN(10)) phase_lnv(p);
    SEAM(10);
    if (RUN(11)) phase_spatial(p, lds);
    SEAM(11);
    if (RUN(12)) { pg8::Gemm g{BIG, (const bf16_t*)(ws + WS_CMWOUT), T, 1024, 2048, 4096}; pg8::StaticOrder S; S.init(T, 1024, G, bid);
        pg8::EpiRes E{Y, Y + (size_t)TP * 1024, Y, DN_ALPHA};
        pg8::gemm_phase<pg8::EpiRes, pg8::StaticOrder, true, true>(lds, g, S, E); }
    SEAM(12);
    if (RUN(13)) phase_ln(Y, Y, XB, p.in[21] + 1024, p.in[22] + 1024);
    SEAM(13);
    if (RUN(14)) { pg8::Gemm g{XB, (const bf16_t*)(ws + WS_W1) + (size_t)4096 * 1024, T, 4096, 1024, 1024}; pg8::StaticOrder S; S.init(T, 4096, G, bid);
        pg8::EpiAct<1> E{BIG, 4096, nullptr};
        pg8::gemm_phase<pg8::EpiAct<1>, pg8::StaticOrder, true, true>(lds, g, S, E); }
    SEAM(14);
    if (RUN(15)) { pg8::Gemm g{BIG, (const bf16_t*)(ws + WS_W2) + (size_t)4096 * 1024, T, 1024, 4096, 4096}; pg8::StaticOrder S; S.init(T, 1024, G, bid);
        pg8::EpiRes E{Y, Y + (size_t)TP * 1024, Y, DN_ALPHA};
        pg8::gemm_phase<pg8::EpiRes, pg8::StaticOrder, true, true>(lds, g, S, E); }
    SEAM(15);
    if (RUN(16)) phase_ln(Y, Y, nullptr, p.in[23] + 1024, p.in[24] + 1024);
}

#ifndef ONE_LAUNCH
#define ONE_LAUNCH 0
#endif
extern "C" void kernel_launch(void* const* d_in, const int* in_sizes, int n_in, void* d_out, int out_size, void* d_ws, size_t ws_size, hipStream_t stream) {
    static int grid = 0;
    if (grid == 0) {
        if (n_in != 25 || ws_size < WS_END) { fprintf(stderr, "kernel_launch: unexpected n_in %d / ws_size %zu\n", n_in, ws_size); grid = -1; return; }
        int dev = 0, cus = 0, per_cu = 0;
        hipGetDevice(&dev); hipDeviceGetAttribute(&cus, hipDeviceAttributeMultiprocessorCount, dev);
        if (hipFuncSetAttribute((const void*)fwd_kernel, hipFuncAttributeMaxDynamicSharedMemorySize, LDS_BYTES) != hipSuccess) { fprintf(stderr, "kernel_launch: hipFuncSetAttribute failed\n"); grid = -1; return; }
        hipOccupancyMaxActiveBlocksPerMultiprocessor(&per_cu, (const void*)fwd_kernel, 512, LDS_BYTES);
        if (per_cu < 1) { fprintf(stderr, "kernel_launch: occupancy query says %d blocks per CU\n", per_cu); per_cu = 1; }
        (void)hipGetLastError();
        grid = cus;
    }
    if (grid < 0) return;
    Params p{};
    for (int i = 0; i < 25; ++i) p.in[i] = (const float*)d_in[i];
    p.out = (float*)d_out; p.ws = (unsigned char*)d_ws;
#if ONE_LAUNCH
    p.ph_lo = 0; p.ph_hi = NPHASE - 1;
    void* args[] = {&p};
    hipError_t e = hipLaunchCooperativeKernel((const void*)fwd_kernel, dim3(grid), dim3(512), args, LDS_BYTES, stream);
    if (e != hipSuccess) fprintf(stderr, "cooperative launch failed: %s (grid %d)\n", hipGetErrorString(e), grid);
#else
    for (int ph = 0; ph < NPHASE; ++ph) { p.ph_lo = ph; p.ph_hi = ph; hipLaunchKernelGGL(fwd_kernel, dim3(grid), dim3(512), LDS_BYTES, stream, p); }
#endif
}
```

```cpp
#include <hip/hip_runtime.h>
#include <hip/hip_cooperative_groups.h>
#include <cstdio>
#include <cstdint>
namespace cg = cooperative_groups;
#ifndef PHMASK
#define PHMASK 0x1ffff
#endif
#ifndef USE_CG_SYNC
#define USE_CG_SYNC 0
#endif
#ifndef ONE_LAUNCH
#define ONE_LAUNCH 1
#endif
namespace pg8 {
#define PG8_LAS __attribute__((address_space(3)))
typedef unsigned short bf16_t;
typedef short bf16x8 __attribute__((ext_vector_type(8)));
typedef float f32x4 __attribute__((ext_vector_type(4)));
typedef unsigned u32x4 __attribute__((ext_vector_type(4)));
constexpr int BM = 256, BK = 64, HALF = 128, HTB = HALF * BK * 2  , STAGE_BYTES = 8 * HTB, NXCD = 8, WGM = 8;

__host__ __device__ __forceinline__ int lds_byte(int r, int c) { const int st = (r >> 4) * 2 + (c >> 5), rr = r & 15, cc = c & 31, ob = rr * 64 + cc * 2; return st * 1024 + (ob ^ (((ob >> 9) & 1) << 5)); }
__host__ __device__ __forceinline__ void stage_rc(int b, int& R, int& C) { const int st = b / 1024, sb = b % 1024, swz = sb ^ (((sb >> 9) & 1) << 5); R = (st >> 1) * 16 + swz / 64; C = (st & 1) * 32 + (swz % 64) / 2; }
__host__ __device__ __forceinline__ int perm32(int rho) { const int n = rho >> 4, i = rho & 15; return 8 * (i >> 2) + 4 * n + (i & 3); }

struct Unit { int pm, pn; };
struct Gemm { const bf16_t* A; const bf16_t* Bt; int M, N, K, lda; };

struct StaticOrder {
    int nM, nN, nwg, G, c;
    __host__ __device__ void init(int M, int N, int G_, int c_) { nM = M / BM; nN = N / BM; nwg = nM * nN; G = G_; c = c_; }
    __host__ __device__ bool next(int i, Unit& u) const {
        const long L = (long)i * G + c; if (L >= nwg) return false;
        int wgid = (int)L; { const int q = nwg / NXCD, r = nwg % NXCD, xcd = wgid % NXCD, off = wgid / NXCD; wgid = (xcd < r ? xcd * (q + 1) : r * (q + 1) + (xcd - r) * q) + off; }
        const int nig = WGM * nN, gid = wgid / nig, fm = gid * WGM, gsz = (nM - fm) < WGM ? (nM - fm) : WGM;
        u.pm = fm + ((wgid % nig) % gsz); u.pn = (wgid % nig) / gsz; return true;
    }
    __device__ __forceinline__ void a_ready(const Unit&) const {}
    __device__ __forceinline__ void done(const Unit&) const {}
};
__device__ __forceinline__ unsigned cvt_pk_bf16(float lo, float hi) { unsigned r; asm volatile("v_cvt_pk_bf16_f32 %0, %1, %2" : "=v"(r) : "v"(lo), "v"(hi)); return r; }

constexpr int TP_ROWS = 16384;
struct EpiG1 {
    static constexpr bool PERM = true, AFTER_DRAIN = false;
    bf16_t* Z; bf16_t* XBC;
    __device__ __forceinline__ void operator()(const f32x4 (&acc)[2][2][4][2], const Unit& u, int wr, int wc, int fr, int fq) const {
        const int row0 = u.pm * BM + wr * 64 + fr; const int colt = u.pn * BM;
        const bool isx = colt >= 2048;
        bf16_t* base = isx ? XBC : Z; const int ldc = isx ? 4096 : 2048; const int col0 = (isx ? colt - 2048 : colt) + wc * 32 + 8 * fq;
#pragma unroll
        for (int ai = 0; ai < 2; ++ai)
#pragma unroll
            for (int m = 0; m < 4; ++m) { bf16_t* rowp = base + (size_t)(row0 + ai * HALF + m * 16) * ldc + col0;
#pragma unroll
                for (int bj = 0; bj < 2; ++bj) { const f32x4 v0 = acc[ai][bj][m][0], v1 = acc[ai][bj][m][1];
                    u32x4 w; w.x = cvt_pk_bf16(v0[0], v0[1]); w.y = cvt_pk_bf16(v0[2], v0[3]); w.z = cvt_pk_bf16(v1[0], v1[1]); w.w = cvt_pk_bf16(v1[2], v1[3]);
                    *(u32x4*)(rowp + bj * HALF) = w; } }
    }
};
__device__ __forceinline__ float act_relu2(float v) { const float r = v > 0.f ? v : 0.f; return r * r; }
__device__ __forceinline__ float act_gelu_tanh(float v) { const float u = 0.7978845608f * (v + 0.044715f * v * v * v); return v / (1.0f + __expf(-2.0f * u)); }
template <int ACT> struct EpiAct {
    static constexpr bool PERM = true, AFTER_DRAIN = false;
    bf16_t* O; int ldc; const float* bias;
    __device__ __forceinline__ void operator()(const f32x4 (&acc)[2][2][4][2], const Unit& u, int wr, int wc, int fr, int fq) const {
        const int row0 = u.pm * BM + wr * 64 + fr; const int col0 = u.pn * BM + wc * 32 + 8 * fq;
        f32x4 bv[2][2];
#pragma unroll
        for (int bj = 0; bj < 2; ++bj)
#pragma unroll
            for (int n = 0; n < 2; ++n) bv[bj][n] = (ACT == 2) ? *(const f32x4*)(bias + col0 + bj * HALF + 4 * n) : (f32x4){0.f, 0.f, 0.f, 0.f};
#pragma unroll
        for (int ai = 0; ai < 2; ++ai)
#pragma unroll
            for (int m = 0; m < 4; ++m) { bf16_t* rowp = O + (size_t)(row0 + ai * HALF + m * 16) * ldc + col0;
#pragma unroll
                for (int bj = 0; bj < 2; ++bj) { f32x4 v0 = acc[ai][bj][m][0] + bv[bj][0], v1 = acc[ai][bj][m][1] + bv[bj][1];
#pragma unroll
                    for (int j = 0; j < 4; ++j) { if (ACT == 1) { v0[j] = act_relu2(v0[j]); v1[j] = act_relu2(v1[j]); } else { v0[j] = act_gelu_tanh(v0[j]); v1[j] = act_gelu_tanh(v1[j]); } }
                    u32x4 w; w.x = cvt_pk_bf16(v0[0], v0[1]); w.y = cvt_pk_bf16(v0[2], v0[3]); w.z = cvt_pk_bf16(v1[0], v1[1]); w.w = cvt_pk_bf16(v1[2], v1[3]);
                    *(u32x4*)(rowp + bj * HALF) = w; } }
    }
};
struct EpiRes {
    static constexpr bool PERM = false, AFTER_DRAIN = false;
    const float* resP; const float* resS; float* out; float alpha;
    __device__ __forceinline__ void operator()(const f32x4 (&acc)[2][2][4][2], const Unit& u, int wr, int wc, int fr, int fq) const {
        const int row0 = u.pm * BM + wr * 64 + fr, col0 = u.pn * BM + wc * 32 + 4 * fq;
#pragma unroll
        for (int ai = 0; ai < 2; ++ai)
#pragma unroll
            for (int m = 0; m < 4; ++m) { const int row = row0 + ai * HALF + m * 16;
                const float* rp = (row < TP_ROWS ? resP + (size_t)row * 1024 : resS + (size_t)(row - TP_ROWS) * 1024) + col0; float* op = out + (size_t)row * 1024 + col0;
#pragma unroll
                for (int bj = 0; bj < 2; ++bj)
#pragma unroll
                    for (int n = 0; n < 2; ++n) { const f32x4 r = *(const f32x4*)(rp + bj * HALF + n * 16); *(f32x4*)(op + bj * HALF + n * 16) = r * alpha + acc[ai][bj][m][n]; } }
    }
};
template <class Epi, class Sched, bool ALIGN_EPI = false, bool SP2 = false>
__device__ __forceinline__ void gemm_phase(PG8_LAS unsigned char* lds, const Gemm g, const Sched& S, const Epi& E) {
    const int tid = threadIdx.x, wid = __builtin_amdgcn_readfirstlane(tid >> 6), lane = tid & 63, wr = wid >> 2, wc = wid & 3, fr = lane & 15, fq = lane >> 4;
    const int K = g.K, nt = K / BK;
    unsigned voffA[2], voffB[2];
#pragma unroll
    for (int i = 0; i < 2; ++i) { int R, C; stage_rc(tid * 16 + i * 8192, R, C); const int Rb = Epi::PERM ? ((R & ~31) + perm32(R & 31)) : R;
        voffA[i] = (unsigned)(R * g.lda + C) * 2u; voffB[i] = (unsigned)(Rb * K + C) * 2u; }
    const size_t kstep = (size_t)(BK * 2);
    const size_t hstepA = (size_t)HALF * g.lda * 2, hstepB = (size_t)HALF * K * 2;
    const size_t tstepA = 2 * hstepA, tstepB = 2 * hstepB;
    const unsigned ldsw = (unsigned)wid * 1024u;
    const int aoff = lds_byte(wr * 64 + fr, fq * 8), boff = lds_byte(wc * 32 + fr, fq * 8);
#define PG8_SA(b, h) (((b) * 2 + (h)) * HTB)
#define PG8_SB(b, h) ((4 + (b) * 2 + (h)) * HTB)
#define PG8_STAGE(bufoff, gbase, voff) do { _Pragma("unroll") for (int _i = 0; _i < 2; ++_i) \
        __builtin_amdgcn_global_load_lds((const unsigned*)((const char*)(gbase) + (voff)[_i]), (PG8_LAS unsigned*)(lds + (bufoff) + ldsw + _i * 8192), 16, 0, 0); } while (0)
#define PG8_LDA(dst, b, h) do { _Pragma("unroll") for (int m = 0; m < 4; ++m) _Pragma("unroll") for (int k = 0; k < 2; ++k) dst[m][k] = *(const PG8_LAS bf16x8*)(lds + PG8_SA(b, h) + aoff + m * 2048 + k * 1024); } while (0)
#define PG8_LDB(dst, b, h) do { _Pragma("unroll") for (int n = 0; n < 2; ++n) _Pragma("unroll") for (int k = 0; k < 2; ++k) dst[n][k] = *(const PG8_LAS bf16x8*)(lds + PG8_SB(b, h) + boff + n * 2048 + k * 1024); } while (0)
#define PG8_MMA(ai, bj, At, Bt) do { __builtin_amdgcn_s_setprio(1); _Pragma("unroll") for (int m = 0; m < 4; ++m) _Pragma("unroll") for (int n = 0; n < 2; ++n) _Pragma("unroll") for (int k = 0; k < 2; ++k) \
        acc[ai][bj][m][n] = __builtin_amdgcn_mfma_f32_16x16x32_bf16(Bt[n][k], At[m][k], acc[ai][bj][m][n], 0, 0, 0); __builtin_amdgcn_s_setprio(0); } while (0)
#define PG8_WAIT_V(n) asm volatile("s_waitcnt vmcnt(" #n ")" ::: "memory")
#define PG8_WAIT_L(n) asm volatile("s_waitcnt lgkmcnt(" #n ")" ::: "memory")
#define PG8_BAR __builtin_amdgcn_s_barrier()
#define PG8_SCHED __builtin_amdgcn_sched_barrier(0)
    Unit cur, nxt; int ui = 0;
    if (!S.next(0, cur)) return;
    f32x4 acc[2][2][4][2];
#pragma unroll
    for (int a = 0; a < 2; ++a)
#pragma unroll
        for (int b = 0; b < 2; ++b)
#pragma unroll
            for (int m = 0; m < 4; ++m)
#pragma unroll
                for (int n = 0; n < 2; ++n) acc[a][b][m][n] = (f32x4){0.f, 0.f, 0.f, 0.f};
    bf16x8 At[4][2], B0[2][2], B1[2][2];
    const char* cA = (const char*)g.A + (size_t)cur.pm * tstepA; const char* cB = (const char*)g.Bt + (size_t)cur.pn * tstepB;
    S.a_ready(cur);
    if constexpr (SP2) {
        PG8_STAGE(PG8_SB(0, 0), cB, voffB); PG8_STAGE(PG8_SB(0, 1), cB + hstepB, voffB); PG8_STAGE(PG8_SA(0, 0), cA, voffA); PG8_STAGE(PG8_SA(0, 1), cA + hstepA, voffA);
        if (wr == 1) PG8_BAR;
        PG8_WAIT_V(2); PG8_BAR;
        PG8_STAGE(PG8_SB(1, 0), cB + kstep, voffB); PG8_STAGE(PG8_SA(1, 0), cA + kstep, voffA); PG8_STAGE(PG8_SB(1, 1), cB + hstepB + kstep, voffB);
        PG8_WAIT_V(6); PG8_BAR;
    } else {
        PG8_STAGE(PG8_SB(0, 0), cB, voffB); PG8_STAGE(PG8_SA(0, 0), cA, voffA); PG8_STAGE(PG8_SB(0, 1), cB + hstepB, voffB); PG8_STAGE(PG8_SA(0, 1), cA + hstepA, voffA);
        if (wr == 1) PG8_BAR;
        PG8_WAIT_V(4); PG8_BAR;
        PG8_STAGE(PG8_SB(1, 0), cB + kstep, voffB); PG8_STAGE(PG8_SA(1, 0), cA + kstep, voffA); PG8_STAGE(PG8_SB(1, 1), cB + hstepB + kstep, voffB);
        PG8_WAIT_V(6); PG8_BAR;
    }
    for (;;) {
        const bool has_next = S.next(ui + 1, nxt);
        const char* nA = has_next ? (const char*)g.A + (size_t)nxt.pm * tstepA : cA; const char* nB = has_next ? (const char*)g.Bt + (size_t)nxt.pn * tstepB : cB;
        for (int t = 0; t < nt; t += 2) {
            const bool last = (t == nt - 2);
            const char* a1 = cA + (size_t)(t + 1) * kstep;
            const char* a2 = last ? nA : cA + (size_t)(t + 2) * kstep; const char* b2 = last ? nB : cB + (size_t)(t + 2) * kstep;
            const char* a3 = a2 + kstep; const char* b3 = b2 + kstep;
            if (last && has_next) S.a_ready(nxt);
            if constexpr (SP2) {
            PG8_LDB(B0, 0, 0); PG8_LDB(B1, 0, 1); PG8_SCHED; PG8_LDA(At, 0, 0); PG8_STAGE(PG8_SA(1, 1), a1 + hstepA, voffA);
            PG8_WAIT_V(8); PG8_WAIT_L(0); PG8_BAR; PG8_MMA(0, 0, At, B0); PG8_MMA(0, 1, At, B1); PG8_BAR; PG8_SCHED;
            PG8_LDA(At, 0, 1); PG8_STAGE(PG8_SB(0, 0), b2, voffB); PG8_STAGE(PG8_SB(0, 1), b2 + hstepB, voffB); PG8_STAGE(PG8_SA(0, 0), a2, voffA);
            PG8_WAIT_V(8); PG8_WAIT_L(0); PG8_BAR; PG8_MMA(1, 0, At, B0); PG8_MMA(1, 1, At, B1); PG8_BAR; PG8_SCHED;
            PG8_LDB(B0, 1, 0); PG8_LDB(B1, 1, 1); PG8_SCHED; PG8_LDA(At, 1, 0); PG8_STAGE(PG8_SA(0, 1), a2 + hstepA, voffA);
            PG8_WAIT_V(8); PG8_WAIT_L(0); PG8_BAR; PG8_MMA(0, 0, At, B0); PG8_MMA(0, 1, At, B1); PG8_BAR; PG8_SCHED;
            PG8_LDA(At, 1, 1); PG8_STAGE(PG8_SB(1, 0), b3, voffB); PG8_STAGE(PG8_SB(1, 1), b3 + hstepB, voffB); PG8_STAGE(PG8_SA(1, 0), a3, voffA);
            PG8_WAIT_V(8); PG8_WAIT_L(0); PG8_BAR; PG8_MMA(1, 0, At, B0); PG8_MMA(1, 1, At, B1); PG8_BAR; PG8_SCHED;
            } else {
            PG8_LDB(B0, 0, 0); PG8_SCHED; PG8_LDA(At, 0, 0); PG8_STAGE(PG8_SA(1, 1), a1 + hstepA, voffA);
            PG8_WAIT_L(8); PG8_BAR; PG8_WAIT_L(0); PG8_MMA(0, 0, At, B0); PG8_BAR; PG8_SCHED;
            PG8_LDB(B1, 0, 1); PG8_STAGE(PG8_SB(0, 0), b2, voffB);
            PG8_BAR; PG8_WAIT_L(0); PG8_MMA(0, 1, At, B1); PG8_BAR;
            PG8_LDA(At, 0, 1); PG8_STAGE(PG8_SA(0, 0), a2, voffA);
            PG8_BAR; PG8_WAIT_L(0); PG8_MMA(1, 0, At, B0); PG8_BAR; PG8_SCHED;
            PG8_STAGE(PG8_SB(0, 1), b2 + hstepB, voffB);
            PG8_WAIT_V(6); PG8_BAR; PG8_MMA(1, 1, At, B1); PG8_BAR;
            PG8_LDB(B0, 1, 0); PG8_SCHED; PG8_LDA(At, 1, 0); PG8_STAGE(PG8_SA(0, 1), a2 + hstepA, voffA);
            PG8_WAIT_L(8); PG8_BAR; PG8_WAIT_L(0); PG8_MMA(0, 0, At, B0); PG8_BAR; PG8_SCHED;
            PG8_LDB(B1, 1, 1); PG8_STAGE(PG8_SB(1, 0), b3, voffB);
            PG8_BAR; PG8_WAIT_L(0); PG8_MMA(0, 1, At, B1); PG8_BAR;
            PG8_LDA(At, 1, 1); PG8_STAGE(PG8_SA(1, 0), a3, voffA);
            PG8_BAR; PG8_WAIT_L(0); PG8_MMA(1, 0, At, B0); PG8_BAR; PG8_SCHED;
            PG8_STAGE(PG8_SB(1, 1), b3 + hstepB, voffB);
            PG8_WAIT_V(6); PG8_BAR; PG8_MMA(1, 1, At, B1); PG8_BAR;
            }
        }
        if constexpr (ALIGN_EPI) { if (wr == 0) PG8_BAR; }
        if constexpr (!Epi::AFTER_DRAIN) { E(acc, cur, wr, wc, fr, fq); S.done(cur); }
        if (!has_next) break;
#pragma unroll
        for (int a = 0; a < 2; ++a)
#pragma unroll
            for (int b = 0; b < 2; ++b)
#pragma unroll
                for (int m = 0; m < 4; ++m)
#pragma unroll
                    for (int n = 0; n < 2; ++n) acc[a][b][m][n] = (f32x4){0.f, 0.f, 0.f, 0.f};
        cur = nxt; cA = nA; cB = nB; ++ui;
        if constexpr (ALIGN_EPI) { if (wr == 1) PG8_BAR; }
    }
    PG8_WAIT_V(0);
    if constexpr (!ALIGN_EPI) { if (wr == 0) PG8_BAR; }
    PG8_BAR;
    if constexpr (Epi::AFTER_DRAIN) { E.fused(acc, cur, wr, wc, fr, fq, lds, wid, lane); S.done(cur); }
#undef PG8_SA
#undef PG8_SB
#undef PG8_STAGE
#undef PG8_LDA
#undef PG8_LDB
#undef PG8_MMA
#undef PG8_WAIT_V
#undef PG8_WAIT_L
#undef PG8_BAR
#undef PG8_SCHED
}
}

#define LAS __attribute__((address_space(3)))
typedef LAS unsigned char* ldsp;
using pg8::bf16_t; using pg8::bf16x8; using pg8::f32x4; using pg8::u32x4; using pg8::cvt_pk_bf16;
typedef unsigned u32x2 __attribute__((ext_vector_type(2)));

#define XB_TMO      128
#define XB_XCNT(j)  (256  + 64 * (j))
#define XB_XSUB(j)  (1280 + 64 * (j))
#define XB_XGEN(j)  (2304 + 64 * (j))
#define XB_TOP      3328
#define XB_TOPGEN   3392
#define XCD_BAR_WORDS 3456
#define XB_SPIN_CAP (1u << 18)

__device__ __forceinline__ unsigned xb_ld(unsigned* p)              { return __hip_atomic_load(p, __ATOMIC_RELAXED, __HIP_MEMORY_SCOPE_AGENT); }
__device__ __forceinline__ unsigned xb_add(unsigned* p, unsigned v) { return __hip_atomic_fetch_add(p, v, __ATOMIC_RELAXED, __HIP_MEMORY_SCOPE_AGENT); }
__device__ __forceinline__ unsigned xb_xcc_id() { return (unsigned)__builtin_amdgcn_s_getreg((3 << 11) | 20) & 0xFu; }
#define XB_SPIN(cond, bar) do { unsigned _sp = 0; while (cond) { __builtin_amdgcn_s_sleep(1); \
    if ((++_sp & 255u) == 0u) { if (xb_ld(&(bar)[XB_TMO])) break; if (_sp > XB_SPIN_CAP) { atomicAdd(&(bar)[XB_TMO], 1u); break; } } } } while (0)

struct XcdBarrier {
    unsigned* bar; unsigned x;
    volatile LAS unsigned* st;
};

__device__ __forceinline__ XcdBarrier xcd_barrier_post(unsigned* bar, volatile LAS unsigned* st) {
    XcdBarrier b; b.bar = bar; b.x = xb_xcc_id(); b.st = st;
    if (threadIdx.x == 0) (void)xb_add(&bar[XB_XCNT(b.x)], 1u);
    return b;
}
__device__ __forceinline__ void xcd_barrier_complete(unsigned* bar, unsigned x, unsigned& nloc, unsigned& nx) {
    const unsigned G = gridDim.x * gridDim.y * gridDim.z;
    unsigned sum, cnt, mine, sp = 0u;
    for (;;) {
        sum = 0u; cnt = 0u; mine = 0u;
#pragma unroll
        for (unsigned j = 0; j < 16; ++j) { const unsigned c = xb_ld(&bar[XB_XCNT(j)]); sum += c; cnt += (c > 0u) ? 1u : 0u; mine = (j == x) ? c : mine; }
        if (sum == G) break;
        __builtin_amdgcn_s_sleep(1);
        if ((++sp & 255u) == 0u) { if (xb_ld(&bar[XB_TMO])) break; if (sp > XB_SPIN_CAP) { atomicAdd(&bar[XB_TMO], 1u); break; } }
    }
    nloc = mine > 0u ? mine : 1u; nx = cnt > 0u ? cnt : 1u;
}

__device__ __forceinline__ void xcd_barrier(const XcdBarrier& b) {
    asm volatile("s_waitcnt vmcnt(0)" ::: "memory");
    __syncthreads();
    if (threadIdx.x == 0) {
        unsigned* bar = b.bar;
        __builtin_amdgcn_s_waitcnt(0);
        unsigned nloc = b.st[0], nx = b.st[1];
        if (nloc == 0u) { xcd_barrier_complete(bar, b.x, nloc, nx); b.st[0] = nloc; b.st[1] = nx; }
        const unsigned old = xb_add(&bar[XB_XSUB(b.x)], 1u);
        const unsigned gen = old / nloc;
        if (old + 1u == (gen + 1u) * nloc) {
            __builtin_amdgcn_fence(__ATOMIC_RELEASE, "agent");
            asm volatile("s_waitcnt vmcnt(0)" ::: "memory");
            const unsigned og = xb_add(&bar[XB_TOP], 1u);
            const unsigned tg = og / nx;
            if (og + 1u == (tg + 1u) * nx) xb_add(&bar[XB_TOPGEN], 1u);
            else XB_SPIN(xb_ld(&bar[XB_TOPGEN]) == tg, bar);
            __builtin_amdgcn_fence(__ATOMIC_ACQUIRE, "agent");
            xb_add(&bar[XB_XGEN(b.x)], 1u);
            asm volatile("s_waitcnt vmcnt(0)" ::: "memory");
        } else {
            XB_SPIN(xb_ld(&bar[XB_XGEN(b.x)]) == gen, bar);
            __builtin_amdgcn_fence(__ATOMIC_ACQUIRE, "agent");
            asm volatile("s_waitcnt vmcnt(0)" ::: "memory");
        }
    }
    __syncthreads();
}

constexpr int T = 18432, TP = 16384, DM = 1024;
constexpr float DN_ALPHA = 1.41421356237f;
constexpr float LN_EPS = 1e-5f;
constexpr size_t O_YP = 0, O_YS = 16777216, O_SSMP = 18874368, O_CONVP = 20971520, O_SSMS = 21069824, O_CONVS = 29458432, O_VROWS = 29851648;
constexpr size_t WS_XB = 0, WS_BIG = 37748736, WS_WIN = 188743680, WS_WOUT = 201392128, WS_W1 = 205586432, WS_W2 = 222363648, WS_CMWIN = 239140864, WS_CMWOUT = 247529472, WS_DT = 251723776, WS_BAR = 254083072, WS_END = 254083072 + 16384;
constexpr int LDS_BYTES = 149504, LDS_BARST = 149472;
constexpr int NPHASE = 17;

struct Params { const float* in[25]; float* out; unsigned char* ws; int ph_lo, ph_hi; };

__device__ __forceinline__ float bf_lo(unsigned w) { return __uint_as_float(w << 16); }
__device__ __forceinline__ float bf_hi(unsigned w) { return __uint_as_float(w & 0xffff0000u); }
__device__ __forceinline__ unsigned short f2bf(float f) { unsigned u = __float_as_uint(f); u += 0x7FFFu + ((u >> 16) & 1u); return (unsigned short)(u >> 16); }
__device__ __forceinline__ float silu_f(float x) { return x / (1.0f + __expf(-x)); }
__device__ __forceinline__ float wave_sum(float v) {
#pragma unroll
    for (int o = 32; o >= 1; o >>= 1) v += __shfl_xor(v, o);
    return v;
}
__device__ __forceinline__ f32x4 mfma16(bf16x8 a, bf16x8 b, f32x4 c) { return __builtin_amdgcn_mfma_f32_16x16x32_bf16(a, b, c, 0, 0, 0); }

__device__ __forceinline__ void transpose_cvt(const float* __restrict__ W, int K, int N, bf16_t* __restrict__ WT, ldsp lds) {
    LAS float* tile = (LAS float*)lds;
    const int tid = threadIdx.x; const int ntn = (N + 63) / 64, ntiles = (K / 64) * ntn;
    for (int t = blockIdx.x; t < ntiles; t += gridDim.x) {
        const int k0 = (t / ntn) * 64, n0 = (t % ntn) * 64;
#pragma unroll
        for (int i = 0; i < 8; ++i) { const int k = (tid >> 6) + 8 * i, n = tid & 63; tile[k * 65 + n] = (n0 + n < N) ? W[(size_t)(k0 + k) * N + n0 + n] : 0.f; }
        __syncthreads();
#pragma unroll
        for (int i = 0; i < 4; ++i) { const int kp = 2 * (tid & 31), nn = (tid >> 5) + 16 * i;
            if (n0 + nn < N) *(unsigned*)(WT + (size_t)(n0 + nn) * K + k0 + kp) = cvt_pk_bf16(tile[kp * 65 + nn], tile[(kp + 1) * 65 + nn]); }
        __syncthreads();
    }
}
__device__ __forceinline__ void phase_prep(const Params& p, ldsp lds) {
    unsigned char* ws = p.ws;
    transpose_cvt(p.in[4], 1024, 6176, (bf16_t*)(ws + WS_WIN), lds);
    transpose_cvt(p.in[11], 2048, 1024, (bf16_t*)(ws + WS_WOUT), lds);
    transpose_cvt(p.in[19], 1024, 4096, (bf16_t*)(ws + WS_W1), lds);
    transpose_cvt(p.in[19] + (size_t)1024 * 4096, 1024, 4096, (bf16_t*)(ws + WS_W1) + (size_t)4096 * 1024, lds);
    transpose_cvt(p.in[20], 4096, 1024, (bf16_t*)(ws + WS_W2), lds);
    transpose_cvt(p.in[20] + (size_t)4096 * 1024, 4096, 1024, (bf16_t*)(ws + WS_W2) + (size_t)4096 * 1024, lds);
    transpose_cvt(p.in[12], 1024, 4096, (bf16_t*)(ws + WS_CMWIN), lds);
    transpose_cvt(p.in[18], 2048, 1024, (bf16_t*)(ws + WS_CMWOUT), lds);
    const f32x4* xp = (const f32x4*)p.in[0]; const f32x4* xs = (const f32x4*)p.in[1]; u32x2* xb = (u32x2*)(ws + WS_XB);
    const int n4p = TP * DM / 4, n4 = T * DM / 4;
    for (int i = blockIdx.x * 512 + threadIdx.x; i < n4; i += gridDim.x * 512) { const f32x4 v = (i < n4p) ? xp[i] : xs[i - n4p]; u32x2 w; w.x = cvt_pk_bf16(v[0], v[1]); w.y = cvt_pk_bf16(v[2], v[3]); xb[i] = w; }
}

__device__ __forceinline__ void phase_dt(const Params& p) {
    const int tid = threadIdx.x, wid = tid >> 6, lane = tid & 63;
    const bf16_t* XB = (const bf16_t*)(p.ws + WS_XB); const bf16_t* WT = (const bf16_t*)(p.ws + WS_WIN) + (size_t)6144 * 1024; float* DT = (float*)(p.ws + WS_DT);
    const float* bias = p.in[7];
    for (int tile = blockIdx.x * 8 + wid; tile < T / 16; tile += gridDim.x * 8) {
        f32x4 a0 = {0.f, 0.f, 0.f, 0.f}, a1 = {0.f, 0.f, 0.f, 0.f};
        const bf16_t* ap = XB + (size_t)(tile * 16 + (lane & 15)) * 1024 + 8 * (lane >> 4);
        const bf16_t* bp0 = WT + (size_t)(lane & 15) * 1024 + 8 * (lane >> 4); const bf16_t* bp1 = bp0 + 16 * 1024;
#pragma unroll 4
        for (int kk = 0; kk < 32; ++kk) { const bf16x8 a = *(const bf16x8*)(ap + kk * 32), b0 = *(const bf16x8*)(bp0 + kk * 32), b1 = *(const bf16x8*)(bp1 + kk * 32); a0 = mfma16(a, b0, a0); a1 = mfma16(a, b1, a1); }
        const int hd = lane & 15; const float bb0 = bias[hd], bb1 = bias[16 + hd];
#pragma unroll
        for (int r = 0; r < 4; ++r) { const int tok = tile * 16 + (lane >> 4) * 4 + r; const float x0 = a0[r] + bb0, x1 = a1[r] + bb1;
            DT[(size_t)tok * 32 + hd] = x0 > 20.f ? x0 : log1pf(__expf(x0)); DT[(size_t)tok * 32 + 16 + hd] = x1 > 20.f ? x1 : log1pf(__expf(x1)); }
    }
}

constexpr int L_RAW = 0, L_MS = 0, L_YF = 9216, L_CS = 44032, L_BS = 61440, L_BT = 78848, L_XDT = 97280, L_XW = 106496, L_XS = 115712, L_HB = 124928, L_CW = 142336, L_DTS = 148736, L_ACS = 148992;
constexpr int RAW_ST = 656, ST128 = 272, ST64 = 144;
__device__ __forceinline__ int scan_chan(int j0, int h, int g) { return j0 < 64 ? h * 64 + j0 : (j0 < 192 ? 2048 + g * 128 + (j0 - 64) : 3072 + g * 128 + (j0 - 192)); }
__device__ __forceinline__ void conv8(ldsp lds, int t, int j0, float (&o)[8]) {
    const LAS float* cw = (const LAS float*)(lds + L_CW);
#pragma unroll
    for (int e = 0; e < 8; ++e) o[e] = cw[4 * 320 + j0 + e];
#pragma unroll
    for (int k = 0; k < 4; ++k) { const u32x4 r = *(const LAS u32x4*)(lds + L_RAW + (t + k) * RAW_ST + j0 * 2);
        const float x[8] = {bf_lo(r.x), bf_hi(r.x), bf_lo(r.y), bf_hi(r.y), bf_lo(r.z), bf_hi(r.z), bf_lo(r.w), bf_hi(r.w)};
#pragma unroll
        for (int e = 0; e < 8; ++e) o[e] += cw[k * 320 + j0 + e] * x[e]; }
#pragma unroll
    for (int e = 0; e < 8; ++e) o[e] = silu_f(o[e]);
}
template <bool DUMMY> __device__ __forceinline__ void phase_scan(const Params& p, ldsp lds) {
    const int tid = threadIdx.x, wid = tid >> 6, lane = tid & 63, fr = lane & 15, fq = lane >> 4;
    const bf16_t* XBC = (const bf16_t*)(p.ws + WS_BIG); bf16_t* Z = (bf16_t*)p.out; const float* DT = (const float*)(p.ws + WS_DT);
    LAS float* cw = (LAS float*)(lds + L_CW); LAS float* dts = (LAS float*)(lds + L_DTS); LAS float* acs = (LAS float*)(lds + L_ACS);
    for (int chain = blockIdx.x; chain < 1280; chain += gridDim.x) {
        int b, h, nsteps, row0; const float* h0 = nullptr; const float* cprev = nullptr; float* hout;
        if (chain < 256) { b = chain >> 5; h = chain & 31; nsteps = 32; row0 = b * 2048; hout = p.out + O_SSMP + (size_t)(b * 32 + h) * 8192; }
        else { const int i = chain - 256; b = i >> 5; h = i & 31; nsteps = 1; row0 = TP + b * 64; h0 = p.in[2] + (size_t)(b * 32 + h) * 8192; cprev = p.in[3] + (size_t)b * 3 * 4096; hout = p.out + O_SSMS + (size_t)(b * 32 + h) * 8192; }
        const int g = h >> 2; const float A_h = -__expf(p.in[8][h]), D_h = p.in[9][h];
        for (int idx = tid; idx < 1600; idx += 512) { const int k = idx / 320, j = idx % 320, ch = scan_chan(j, h, g); cw[idx] = k < 4 ? p.in[5][k * 4096 + ch] : p.in[6][ch]; }
        const int hp = wid >> 1;
        f32x4 hacc[4];
#pragma unroll
        for (int q = 0; q < 4; ++q)
#pragma unroll
            for (int r = 0; r < 4; ++r) { const int pp = hp * 16 + 4 * fq + r, n = (4 * (wid & 1) + q) * 16 + fr; const float v = h0 ? h0[pp * 128 + n] : 0.f; hacc[q][r] = v;
                *(LAS unsigned short*)(lds + L_HB + pp * ST128 + n * 2) = f2bf(v); }
        __syncthreads();
        for (int step = 0; step < nsteps; ++step) {
            const int R = row0 + step * 64;
            for (int idx = tid; idx < 67 * 40; idx += 512) { const int ri = idx / 40, j0 = (idx % 40) * 8, ch = scan_chan(j0, h, g);
                u32x4 val = {0u, 0u, 0u, 0u};
                if (ri >= 3 || step > 0) val = *(const u32x4*)(XBC + (size_t)(R - 3 + ri) * 4096 + ch);
                else if (cprev) { const f32x4 c0 = *(const f32x4*)(cprev + ri * 4096 + ch), c1 = *(const f32x4*)(cprev + ri * 4096 + ch + 4);
                    val.x = cvt_pk_bf16(c0[0], c0[1]); val.y = cvt_pk_bf16(c0[2], c0[3]); val.z = cvt_pk_bf16(c1[0], c1[1]); val.w = cvt_pk_bf16(c1[2], c1[3]); }
                *(LAS u32x4*)(lds + L_RAW + ri * RAW_ST + j0 * 2) = val; }
            const int et = tid >> 3, ec = (tid & 7) * 8;
            const u32x4 zraw = *(const u32x4*)(Z + (size_t)(R + et) * 2048 + h * 64 + ec);
            if (wid == 0) { const float dtv = DT[(size_t)(R + lane) * 32 + h]; float v = dtv * A_h;
#pragma unroll
                for (int d = 1; d < 64; d <<= 1) { const float n = __shfl_up(v, d); if (lane >= d) v += n; }
                dts[lane] = dtv; acs[lane] = v; }
            __syncthreads();
            const float a_last = acs[63];
            if (step == nsteps - 1) {
                float* cdst = (chain < 256 ? p.out + O_CONVP : p.out + O_CONVS) + (size_t)b * 3 * 4096;
                for (int idx = tid; idx < 960; idx += 512) { const int k = idx / 320, j = idx % 320;
                    if (j < 64 || (h & 3) == 0) cdst[k * 4096 + scan_chan(j, h, g)] = __uint_as_float(((unsigned)*(const LAS unsigned short*)(lds + L_RAW + (64 + k) * RAW_ST + j * 2)) << 16); } }
            { float o[8]; conv8(lds, et, ec, o); const float dtv = dts[et], wv = dtv * __expf(a_last - acs[et]);
                u32x4 w; w.x = cvt_pk_bf16(o[0], o[1]); w.y = cvt_pk_bf16(o[2], o[3]); w.z = cvt_pk_bf16(o[4], o[5]); w.w = cvt_pk_bf16(o[6], o[7]);
                *(LAS u32x4*)(lds + L_XS + et * ST64 + ec * 2) = w;
#pragma unroll
                for (int e = 0; e < 8; ++e) { *(LAS unsigned short*)(lds + L_XDT + (ec + e) * ST64 + et * 2) = f2bf(o[e] * dtv); *(LAS unsigned short*)(lds + L_XW + (ec + e) * ST64 + et * 2) = f2bf(o[e] * wv); } }
#pragma unroll
            for (int i = 0; i < 2; ++i) { const int item = tid + 512 * i, t = item >> 4, n0 = (item & 15) * 8; float o[8];
                conv8(lds, t, 64 + n0, o);
                { u32x4 w; w.x = cvt_pk_bf16(o[0], o[1]); w.y = cvt_pk_bf16(o[2], o[3]); w.z = cvt_pk_bf16(o[4], o[5]); w.w = cvt_pk_bf16(o[6], o[7]); *(LAS u32x4*)(lds + L_BS + t * ST128 + n0 * 2) = w; }
#pragma unroll
                for (int e = 0; e < 8; ++e) *(LAS unsigned short*)(lds + L_BT + (n0 + e) * ST64 + t * 2) = f2bf(o[e]);
                conv8(lds, t, 192 + n0, o);
                { u32x4 w; w.x = cvt_pk_bf16(o[0], o[1]); w.y = cvt_pk_bf16(o[2], o[3]); w.z = cvt_pk_bf16(o[4], o[5]); w.w = cvt_pk_bf16(o[6], o[7]); *(LAS u32x4*)(lds + L_CS + t * ST128 + n0 * 2) = w; } }
            __syncthreads();
            const int ti = wid >> 1;
            f32x4 yacc[2];
            { bf16x8 af[4];
#pragma unroll
                for (int kk = 0; kk < 4; ++kk) af[kk] = *(const LAS bf16x8*)(lds + L_CS + (ti * 16 + fr) * ST128 + (kk * 32 + 8 * fq) * 2);
                float act[4];
#pragma unroll
                for (int r = 0; r < 4; ++r) act[r] = acs[ti * 16 + 4 * fq + r];
#pragma unroll
                for (int q = 0; q < 2; ++q) { const int si = 2 * (wid & 1) + q; f32x4 cb = {0.f, 0.f, 0.f, 0.f};
#pragma unroll
                    for (int kk = 0; kk < 4; ++kk) cb = mfma16(af[kk], *(const LAS bf16x8*)(lds + L_BS + (si * 16 + fr) * ST128 + (kk * 32 + 8 * fq) * 2), cb);
                    const int s = si * 16 + fr; const float as = acs[s];
#pragma unroll
                    for (int r = 0; r < 4; ++r) { const int t = ti * 16 + 4 * fq + r; const float mv = (s <= t) ? cb[r] * __expf(act[r] - as) : 0.f; *(LAS unsigned short*)(lds + L_MS + t * ST64 + s * 2) = f2bf(mv); } }
#pragma unroll
                for (int q = 0; q < 2; ++q) { const int pi = 2 * (wid & 1) + q; f32x4 y = {0.f, 0.f, 0.f, 0.f};
#pragma unroll
                    for (int kk = 0; kk < 4; ++kk) y = mfma16(af[kk], *(const LAS bf16x8*)(lds + L_HB + (pi * 16 + fr) * ST128 + (kk * 32 + 8 * fq) * 2), y);
#pragma unroll
                    for (int r = 0; r < 4; ++r) y[r] *= __expf(act[r]);
                    yacc[q] = y; } }
            __syncthreads();
            {
#pragma unroll
                for (int q = 0; q < 2; ++q) { const int pi = 2 * (wid & 1) + q;
#pragma unroll
                    for (int kk = 0; kk < 2; ++kk) yacc[q] = mfma16(*(const LAS bf16x8*)(lds + L_MS + (ti * 16 + fr) * ST64 + (kk * 32 + 8 * fq) * 2), *(const LAS bf16x8*)(lds + L_XDT + (pi * 16 + fr) * ST64 + (kk * 32 + 8 * fq) * 2), yacc[q]);
#pragma unroll
                    for (int r = 0; r < 4; ++r) *(LAS float*)(lds + L_YF + (ti * 16 + 4 * fq + r) * ST128 + (pi * 16 + fr) * 4) = yacc[q][r]; }
                const float ea = __expf(a_last);
                bf16x8 xa[2];
#pragma unroll
                for (int kk = 0; kk < 2; ++kk) xa[kk] = *(const LAS bf16x8*)(lds + L_XW + (hp * 16 + fr) * ST64 + (kk * 32 + 8 * fq) * 2);
#pragma unroll
                for (int q = 0; q < 4; ++q) { const int ni = 4 * (wid & 1) + q; f32x4 hv = hacc[q] * ea;
#pragma unroll
                    for (int kk = 0; kk < 2; ++kk) hv = mfma16(xa[kk], *(const LAS bf16x8*)(lds + L_BT + (ni * 16 + fr) * ST64 + (kk * 32 + 8 * fq) * 2), hv);
                    hacc[q] = hv;
#pragma unroll
                    for (int r = 0; r < 4; ++r) *(LAS unsigned short*)(lds + L_HB + (hp * 16 + 4 * fq + r) * ST128 + (ni * 16 + fr) * 2) = f2bf(hv[r]); } }
            __syncthreads();
            { const u32x4 xr = *(const LAS u32x4*)(lds + L_XS + et * ST64 + ec * 2);
                const f32x4 y0 = *(const LAS f32x4*)(lds + L_YF + et * ST128 + ec * 4), y1 = *(const LAS f32x4*)(lds + L_YF + et * ST128 + ec * 4 + 16);
                const float xs[8] = {bf_lo(xr.x), bf_hi(xr.x), bf_lo(xr.y), bf_hi(xr.y), bf_lo(xr.z), bf_hi(xr.z), bf_lo(xr.w), bf_hi(xr.w)};
                const float zz[8] = {bf_lo(zraw.x), bf_hi(zraw.x), bf_lo(zraw.y), bf_hi(zraw.y), bf_lo(zraw.z), bf_hi(zraw.z), bf_lo(zraw.w), bf_hi(zraw.w)};
                float gg[8];
#pragma unroll
                for (int e = 0; e < 8; ++e) { const float yv = (e < 4 ? y0[e & 3] : y1[e & 3]) + D_h * xs[e]; gg[e] = yv * silu_f(zz[e]); }
                u32x4 w; w.x = cvt_pk_bf16(gg[0], gg[1]); w.y = cvt_pk_bf16(gg[2], gg[3]); w.z = cvt_pk_bf16(gg[4], gg[5]); w.w = cvt_pk_bf16(gg[6], gg[7]);
                if (DUMMY) *(u32x4*)((bf16_t*)(p.ws + WS_END) + (size_t)(blockIdx.x * 64 + et) * 64 + ec) = w; else *(u32x4*)(Z + (size_t)(R + et) * 2048 + h * 64 + ec) = w; }
            __syncthreads();
        }
#pragma unroll
        for (int q = 0; q < 4; ++q)
#pragma unroll
            for (int r = 0; r < 4; ++r) hout[(hp * 16 + 4 * fq + r) * 128 + (4 * (wid & 1) + q) * 16 + fr] = hacc[q][r];
    }
}

__device__ __forceinline__ void phase_gnorm(const Params& p) {
    const int wid = threadIdx.x >> 6, lane = threadIdx.x & 63; bf16_t* Z = (bf16_t*)p.out; const float* nw = p.in[10];
    for (int row = blockIdx.x * 8 + wid; row < T; row += gridDim.x * 8) {
        bf16_t* zr = Z + (size_t)row * 2048 + 8 * lane;
        u32x4 raw[4];
#pragma unroll
        for (int j = 0; j < 4; ++j) raw[j] = *(const u32x4*)(zr + 512 * j);
#pragma unroll
        for (int j = 0; j < 4; ++j) { const float v[8] = {bf_lo(raw[j].x), bf_hi(raw[j].x), bf_lo(raw[j].y), bf_hi(raw[j].y), bf_lo(raw[j].z), bf_hi(raw[j].z), bf_lo(raw[j].w), bf_hi(raw[j].w)};
            float ss = 0.f;
#pragma unroll
            for (int e = 0; e < 8; ++e) ss += v[e] * v[e];
#pragma unroll
            for (int o = 16; o >= 1; o >>= 1) ss += __shfl_xor(ss, o);
            const float sc = rsqrtf(ss * (1.0f / 256.0f) + LN_EPS);
            const f32x4 w0 = *(const f32x4*)(nw + 512 * j + 8 * lane), w1 = *(const f32x4*)(nw + 512 * j + 8 * lane + 4);
            u32x4 w; w.x = cvt_pk_bf16(v[0] * sc * w0[0], v[1] * sc * w0[1]); w.y = cvt_pk_bf16(v[2] * sc * w0[2], v[3] * sc * w0[3]); w.z = cvt_pk_bf16(v[4] * sc * w1[0], v[5] * sc * w1[1]); w.w = cvt_pk_bf16(v[6] * sc * w1[2], v[7] * sc * w1[3]);
            *(u32x4*)(zr + 512 * j) = w; }
    }
}

__device__ __forceinline__ void phase_ln(const float* src, float* dstf, bf16_t* dstb, const float* gam, const float* bet) {
    const int wid = threadIdx.x >> 6, lane = threadIdx.x & 63;
    f32x4 gv[4], bv[4];
#pragma unroll
    for (int j = 0; j < 4; ++j) { gv[j] = *(const f32x4*)(gam + 256 * j + 4 * lane); bv[j] = *(const f32x4*)(bet + 256 * j + 4 * lane); }
    for (int row = blockIdx.x * 8 + wid; row < T; row += gridDim.x * 8) {
        const float* s = src + (size_t)row * 1024 + 4 * lane; f32x4 v[4]; float sum = 0.f;
#pragma unroll
        for (int j = 0; j < 4; ++j) { v[j] = *(const f32x4*)(s + 256 * j); sum += (v[j][0] + v[j][1]) + (v[j][2] + v[j][3]); }
        const float mean = wave_sum(sum) * (1.0f / 1024.0f); float q = 0.f;
#pragma unroll
        for (int j = 0; j < 4; ++j) { const f32x4 d = v[j] - mean; q += (d[0] * d[0] + d[1] * d[1]) + (d[2] * d[2] + d[3] * d[3]); }
        const float rstd = rsqrtf(wave_sum(q) * (1.0f / 1024.0f) + LN_EPS);
#pragma unroll
        for (int j = 0; j < 4; ++j) { const f32x4 o = (v[j] - mean) * rstd * gv[j] + bv[j];
            *(f32x4*)(dstf + (size_t)row * 1024 + 4 * lane + 256 * j) = o;
            if (dstb) { u32x2 w; w.x = cvt_pk_bf16(o[0], o[1]); w.y = cvt_pk_bf16(o[2], o[3]); *(u32x2*)(dstb + (size_t)row * 1024 + 4 * lane + 256 * j) = w; } }
    }
}

__device__ __forceinline__ void phase_lnv(const Params& p) {
    const int wid = threadIdx.x >> 6, lane = threadIdx.x & 63; bf16_t* BIG = (bf16_t*)(p.ws + WS_BIG); const float* gam = p.in[14]; const float* bet = p.in[15]; float* vrows = p.out + O_VROWS;
    for (int row = blockIdx.x * 8 + wid; row < T; row += gridDim.x * 8) {
        bf16_t* vr = BIG + (size_t)row * 4096 + 2048 + 8 * lane; float v[4][8]; float sum = 0.f;
#pragma unroll
        for (int j = 0; j < 4; ++j) { const u32x4 r = *(const u32x4*)(vr + 512 * j);
            v[j][0] = bf_lo(r.x); v[j][1] = bf_hi(r.x); v[j][2] = bf_lo(r.y); v[j][3] = bf_hi(r.y); v[j][4] = bf_lo(r.z); v[j][5] = bf_hi(r.z); v[j][6] = bf_lo(r.w); v[j][7] = bf_hi(r.w);
#pragma unroll
            for (int e = 0; e < 8; ++e) sum += v[j][e]; }
        const float mean = wave_sum(sum) * (1.0f / 2048.0f); float q = 0.f;
#pragma unroll
        for (int j = 0; j < 4; ++j)
#pragma unroll
            for (int e = 0; e < 8; ++e) { const float d = v[j][e] - mean; q += d * d; }
        const float rstd = rsqrtf(wave_sum(q) * (1.0f / 2048.0f) + LN_EPS);
#pragma unroll
        for (int j = 0; j < 4; ++j) { const int c = 512 * j + 8 * lane;
            const f32x4 g0 = *(const f32x4*)(gam + c), g1 = *(const f32x4*)(gam + c + 4), b0 = *(const f32x4*)(bet + c), b1 = *(const f32x4*)(bet + c + 4);
            f32x4 o0, o1;
#pragma unroll
            for (int e = 0; e < 4; ++e) { o0[e] = (v[j][e] - mean) * rstd * g0[e] + b0[e]; o1[e] = (v[j][4 + e] - mean) * rstd * g1[e] + b1[e]; }
            u32x4 w; w.x = cvt_pk_bf16(o0[0], o0[1]); w.y = cvt_pk_bf16(o0[2], o0[3]); w.z = cvt_pk_bf16(o1[0], o1[1]); w.w = cvt_pk_bf16(o1[2], o1[3]);
            *(u32x4*)(vr + 512 * j) = w;
            if (row >= TP) { float* d = vrows + (size_t)(row - TP) * 2048 + c; *(f32x4*)d = o0; *(f32x4*)(d + 4) = o1; } }
    }
}

constexpr int SP_VT = 0, SP_WS = 69632, SP_SO = 0, SP_VST = 272, SP_SOST = 528;
template <bool DUMMY> __device__ __forceinline__ void phase_spatial(const Params& p, ldsp lds) {
    const int tid = threadIdx.x, wid = tid >> 6, lane = tid & 63, fr = lane & 15, fq = lane >> 4;
    bf16_t* BIG = (bf16_t*)(p.ws + WS_BIG); const float* wsp = p.in[16]; const float* bsp = p.in[17];
    for (int unit = blockIdx.x; unit < 1280; unit += gridDim.x) {
        int R, L, g;
        if (unit < 1024) { g = unit & 7; R = (unit >> 3) * 128; L = 128; } else { const int i = unit - 1024; g = i & 7; R = TP + (i >> 3) * 64; L = 64; }
        for (int idx = tid; idx < L * 32; idx += 512) { const int s = idx >> 5, c8 = (idx & 31) * 8; const u32x4 r = *(const u32x4*)(BIG + (size_t)(R + s) * 4096 + 2048 + g * 256 + c8);
            const unsigned wv[4] = {r.x, r.y, r.z, r.w};
#pragma unroll
            for (int e = 0; e < 4; ++e) { *(LAS unsigned short*)(lds + SP_VT + (c8 + 2 * e) * SP_VST + s * 2) = (unsigned short)(wv[e] & 0xffffu); *(LAS unsigned short*)(lds + SP_VT + (c8 + 2 * e + 1) * SP_VST + s * 2) = (unsigned short)(wv[e] >> 16); } }
        for (int idx = tid; idx < L * (L / 4); idx += 512) { const int t = idx / (L / 4), s0 = (idx % (L / 4)) * 4; const f32x4 w = *(const f32x4*)(wsp + (size_t)(g * 128 + t) * 128 + s0);
            u32x2 o; o.x = cvt_pk_bf16(s0 <= t ? w[0] : 0.f, s0 + 1 <= t ? w[1] : 0.f); o.y = cvt_pk_bf16(s0 + 2 <= t ? w[2] : 0.f, s0 + 3 <= t ? w[3] : 0.f);
            *(LAS u32x2*)(lds + SP_WS + t * SP_VST + s0 * 2) = o; }
        __syncthreads();
        const int nT = L / 16, nK = L / 32;
        f32x4 acc[8][2];
#pragma unroll
        for (int ti = 0; ti < 8; ++ti) { acc[ti][0] = (f32x4){0.f, 0.f, 0.f, 0.f}; acc[ti][1] = (f32x4){0.f, 0.f, 0.f, 0.f}; }
#pragma unroll
        for (int kk = 0; kk < 4; ++kk) if (kk < nK) {
            const bf16x8 b0 = *(const LAS bf16x8*)(lds + SP_VT + (wid * 32 + fr) * SP_VST + (kk * 32 + 8 * fq) * 2), b1 = *(const LAS bf16x8*)(lds + SP_VT + (wid * 32 + 16 + fr) * SP_VST + (kk * 32 + 8 * fq) * 2);
#pragma unroll
            for (int ti = 0; ti < 8; ++ti) if (ti < nT && 32 * kk <= 16 * ti + 15) { const bf16x8 a = *(const LAS bf16x8*)(lds + SP_WS + (ti * 16 + fr) * SP_VST + (kk * 32 + 8 * fq) * 2);
                acc[ti][0] = mfma16(a, b0, acc[ti][0]); acc[ti][1] = mfma16(a, b1, acc[ti][1]); } }
        __syncthreads();
#pragma unroll
        for (int ti = 0; ti < 8; ++ti) if (ti < nT) {
#pragma unroll
            for (int r = 0; r < 4; ++r) { const int t = ti * 16 + 4 * fq + r; const float bb = bsp[g * 128 + t];
                *(LAS unsigned short*)(lds + SP_SO + t * SP_SOST + (wid * 32 + fr) * 2) = f2bf(acc[ti][0][r] + bb); *(LAS unsigned short*)(lds + SP_SO + t * SP_SOST + (wid * 32 + 16 + fr) * 2) = f2bf(acc[ti][1][r] + bb); } }
        __syncthreads();
        for (int idx = tid; idx < L * 32; idx += 512) { const int t = idx >> 5, c8 = (idx & 31) * 8; bf16_t* up = BIG + (size_t)(R + t) * 4096 + g * 256 + c8;
            const u32x4 uu = *(const u32x4*)up; const u32x4 ss = *(const LAS u32x4*)(lds + SP_SO + t * SP_SOST + c8 * 2);
            u32x4 w; w.x = cvt_pk_bf16(bf_lo(uu.x) * bf_lo(ss.x), bf_hi(uu.x) * bf_hi(ss.x)); w.y = cvt_pk_bf16(bf_lo(uu.y) * bf_lo(ss.y), bf_hi(uu.y) * bf_hi(ss.y));
            w.z = cvt_pk_bf16(bf_lo(uu.z) * bf_lo(ss.z), bf_hi(uu.z) * bf_hi(ss.z)); w.w = cvt_pk_bf16(bf_lo(uu.w) * bf_lo(ss.w), bf_hi(uu.w) * bf_hi(ss.w));
            if (DUMMY) *(u32x4*)((bf16_t*)(p.ws + WS_END) + (size_t)blockIdx.x * 16384 + (t & 63) * 256 + c8) = w; else *(u32x4*)up = w; }
        __syncthreads();
    }
}

__global__ void __launch_bounds__(512, 2) fwd_kernel(Params p) {
    extern __shared__ __attribute__((aligned(16))) unsigned char smem[];
    ldsp lds = (ldsp)smem;
    cg::grid_group grid = cg::this_grid();
    if (threadIdx.x < 4) ((LAS unsigned*)(lds + LDS_BARST))[threadIdx.x] = 0u;
    __syncthreads();
    XcdBarrier bar; bar.bar = (unsigned*)(p.ws + WS_BAR); bar.x = 0; bar.st = (volatile LAS unsigned*)(lds + LDS_BARST);
    if (p.ph_hi > p.ph_lo) bar = xcd_barrier_post((unsigned*)(p.ws + WS_BAR), (volatile LAS unsigned*)(lds + LDS_BARST));
    unsigned char* ws = p.ws; const int G = gridDim.x, bid = blockIdx.x;
    bf16_t* XB = (bf16_t*)(ws + WS_XB); bf16_t* BIG = (bf16_t*)(ws + WS_BIG); float* Y = p.out; bf16_t* Zb = (bf16_t*)p.out;
#ifndef REPMASK
#define REPMASK 0
#endif
#define RUN(k) (((PHMASK >> (k)) & 1) && p.ph_lo <= (k) && (k) <= p.ph_hi)
#define DO2(k, ...) do { if ((REPMASK >> (k)) & 1) { __VA_ARGS__ } __VA_ARGS__ } while (0)
#if USE_CG_SYNC
#define SEAM(k) do { if (p.ph_lo <= (k) && (k) < p.ph_hi) grid.sync(); } while (0)
#else
#define SEAM(k) do { if (p.ph_lo <= (k) && (k) < p.ph_hi) xcd_barrier(bar); } while (0)
#endif
    if (RUN(0)) DO2(0, { phase_prep(p, lds); });
    SEAM(0);
    if (RUN(1)) DO2(1, { pg8::Gemm g{XB, (const bf16_t*)(ws + WS_WIN), T, 6144, 1024, 1024}; pg8::StaticOrder S; S.init(T, 6144, G, bid);
        pg8::EpiG1 E{Zb, BIG};
        pg8::gemm_phase<pg8::EpiG1, pg8::StaticOrder, true, true>(lds, g, S, E);
        phase_dt(p); });
    SEAM(1);
#ifdef PROBE_SCAN2
    if (RUN(2)) phase_scan<true>(p, lds);
#endif
    if (RUN(2)) phase_scan<false>(p, lds);
    SEAM(2);
    if (RUN(3)) phase_gnorm(p);
    SEAM(3);
    if (RUN(4)) DO2(4, { pg8::Gemm g{Zb, (const bf16_t*)(ws + WS_WOUT), T, 1024, 2048, 2048}; pg8::StaticOrder S; S.init(T, 1024, G, bid);
        pg8::EpiRes E{p.in[0], p.in[1], (float*)(ws + WS_BIG), DN_ALPHA};
        pg8::gemm_phase<pg8::EpiRes, pg8::StaticOrder, true, true>(lds, g, S, E); });
    SEAM(4);
    if (RUN(5)) DO2(5, { phase_ln((const float*)(ws + WS_BIG), Y, XB, p.in[21], p.in[22]); });
    SEAM(5);
    if (RUN(6)) DO2(6, { pg8::Gemm g{XB, (const bf16_t*)(ws + WS_W1), T, 4096, 1024, 1024}; pg8::StaticOrder S; S.init(T, 4096, G, bid);
        pg8::EpiAct<1> E{BIG, 4096, nullptr};
        pg8::gemm_phase<pg8::EpiAct<1>, pg8::StaticOrder, true, true>(lds, g, S, E); });
    SEAM(6);
    if (RUN(7)) { pg8::Gemm g{BIG, (const bf16_t*)(ws + WS_W2), T, 1024, 4096, 4096}; pg8::StaticOrder S; S.init(T, 1024, G, bid);
        pg8::EpiRes E{Y, Y + (size_t)TP * 1024, Y, DN_ALPHA};
        pg8::gemm_phase<pg8::EpiRes, pg8::StaticOrder, true, true>(lds, g, S, E); }
    SEAM(7);
    if (RUN(8)) phase_ln(Y, Y, XB, p.in[23], p.in[24]);
    SEAM(8);
    if (RUN(9)) DO2(9, { pg8::Gemm g{XB, (const bf16_t*)(ws + WS_CMWIN), T, 4096, 1024, 1024}; pg8::StaticOrder S; S.init(T, 4096, G, bid);
        pg8::EpiAct<2> E{BIG, 4096, p.in[13]};
        pg8::gemm_phase<pg8::EpiAct<2>, pg8::StaticOrder, true, true>(lds, g, S, E); });
    SEAM(9);
    if (RUN(10)) phase_lnv(p);
    SEAM(10);
#ifdef PROBE_SPATIAL2
    if (RUN(11)) phase_spatial<true>(p, lds);
#endif
    if (RUN(11)) phase_spatial<false>(p, lds);
#ifdef PROBE_SYNC
    for (int i_ = 0; i_ < 16; ++i_) grid.sync();
#endif
    SEAM(11);
    if (RUN(12)) { pg8::Gemm g{BIG, (const bf16_t*)(ws + WS_CMWOUT), T, 1024, 2048, 4096}; pg8::StaticOrder S; S.init(T, 1024, G, bid);
        pg8::EpiRes E{Y, Y + (size_t)TP * 1024, Y, DN_ALPHA};
        pg8::gemm_phase<pg8::EpiRes, pg8::StaticOrder, true, true>(lds, g, S, E); }
    SEAM(12);
    if (RUN(13)) phase_ln(Y, Y, XB, p.in[21] + 1024, p.in[22] + 1024);
    SEAM(13);
    if (RUN(14)) DO2(14, { pg8::Gemm g{XB, (const bf16_t*)(ws + WS_W1) + (size_t)4096 * 1024, T, 4096, 1024, 1024}; pg8::StaticOrder S; S.init(T, 4096, G, bid);
        pg8::EpiAct<1> E{BIG, 4096, nullptr};
        pg8::gemm_phase<pg8::EpiAct<1>, pg8::StaticOrder, true, true>(lds, g, S, E); });
    SEAM(14);
    if (RUN(15)) { pg8::Gemm g{BIG, (const bf16_t*)(ws + WS_W2) + (size_t)4096 * 1024, T, 1024, 4096, 4096}; pg8::StaticOrder S; S.init(T, 1024, G, bid);
        pg8::EpiRes E{Y, Y + (size_t)TP * 1024, Y, DN_ALPHA};
        pg8::gemm_phase<pg8::EpiRes, pg8::StaticOrder, true, true>(lds, g, S, E); }
    SEAM(15);
    if (RUN(16)) phase_ln(Y, Y, nullptr, p.in[23] + 1024, p.in[24] + 1024);
    if (p.ph_lo > 1000) grid.sync();
}

#ifndef ONE_LAUNCH
#define ONE_LAUNCH 0
#endif
extern "C" void kernel_launch(void* const* d_in, const int* in_sizes, int n_in, void* d_out, int out_size, void* d_ws, size_t ws_size, hipStream_t stream) {
    static int grid = 0;
    if (grid == 0) {
        if (n_in != 25 || ws_size < WS_END) { fprintf(stderr, "kernel_launch: unexpected n_in %d / ws_size %zu\n", n_in, ws_size); grid = -1; return; }
        int dev = 0, cus = 0, per_cu = 0;
        hipGetDevice(&dev); hipDeviceGetAttribute(&cus, hipDeviceAttributeMultiprocessorCount, dev);
        if (hipFuncSetAttribute((const void*)fwd_kernel, hipFuncAttributeMaxDynamicSharedMemorySize, LDS_BYTES) != hipSuccess) { fprintf(stderr, "kernel_launch: hipFuncSetAttribute failed\n"); grid = -1; return; }
        hipOccupancyMaxActiveBlocksPerMultiprocessor(&per_cu, (const void*)fwd_kernel, 512, LDS_BYTES);
        if (per_cu < 1) { fprintf(stderr, "kernel_launch: occupancy query says %d blocks per CU\n", per_cu); per_cu = 1; }
        (void)hipGetLastError();
        grid = cus;
    }
    if (grid < 0) return;
    if (hipMemsetAsync((char*)d_ws + WS_BAR, 0, 16384, stream) != hipSuccess) { fprintf(stderr, "kernel_launch: memset failed\n"); return; }
    Params p{};
    for (int i = 0; i < 25; ++i) p.in[i] = (const float*)d_in[i];
    p.out = (float*)d_out; p.ws = (unsigned char*)d_ws;
#if ONE_LAUNCH
    p.ph_lo = 0; p.ph_hi = NPHASE - 1;
    void* args[] = {&p};
    hipError_t e = hipLaunchCooperativeKernel((const void*)fwd_kernel, dim3(grid), dim3(512), args, LDS_BYTES, stream);
    if (e != hipSuccess) fprintf(stderr, "cooperative launch failed: %s (grid %d)\n", hipGetErrorString(e), grid);
#else
    for (int ph = 0; ph < NPHASE; ++ph) { p.ph_lo = ph; p.ph_hi = ph; hipLaunchKernelGGL(fwd_kernel, dim3(grid), dim3(512), LDS_BYTES, stream, p); }
#endif
}
```

```cpp
#include <hip/hip_runtime.h>
#include <hip/hip_cooperative_groups.h>
#include <cstdio>
#include <cstdint>
namespace cg = cooperative_groups;
#ifndef PHMASK
#define PHMASK 0x1ffff
#endif
#ifndef USE_CG_SYNC
#define USE_CG_SYNC 0
#endif
#ifndef ONE_LAUNCH
#define ONE_LAUNCH 1
#endif
namespace pg8 {
#define PG8_LAS __attribute__((address_space(3)))
typedef unsigned short bf16_t;
typedef short bf16x8 __attribute__((ext_vector_type(8)));
typedef float f32x4 __attribute__((ext_vector_type(4)));
typedef unsigned u32x4 __attribute__((ext_vector_type(4)));
constexpr int BM = 256, BK = 64, HALF = 128, HTB = HALF * BK * 2  , STAGE_BYTES = 8 * HTB, NXCD = 8, WGM = 8;

__host__ __device__ __forceinline__ int lds_byte(int r, int c) { const int st = (r >> 4) * 2 + (c >> 5), rr = r & 15, cc = c & 31, ob = rr * 64 + cc * 2; return st * 1024 + (ob ^ (((ob >> 9) & 1) << 5)); }
__host__ __device__ __forceinline__ void stage_rc(int b, int& R, int& C) { const int st = b / 1024, sb = b % 1024, swz = sb ^ (((sb >> 9) & 1) << 5); R = (st >> 1) * 16 + swz / 64; C = (st & 1) * 32 + (swz % 64) / 2; }
__host__ __device__ __forceinline__ int perm32(int rho) { const int n = rho >> 4, i = rho & 15; return 8 * (i >> 2) + 4 * n + (i & 3); }

struct Unit { int pm, pn, kofs, nt, slab; };
struct Gemm { const bf16_t* A; const bf16_t* Bt; int M, N, K, lda; };

struct StaticOrder {
    int nM, nN, nwg, G, c, nt;
    __host__ __device__ void init(int M, int N, int G_, int c_, int K_) { nM = M / BM; nN = N / BM; nwg = nM * nN; G = G_; c = c_; nt = K_ / BK; }
    __host__ __device__ bool next(int i, Unit& u) const {
        const long L = (long)i * G + c; if (L >= nwg) return false;
        int wgid = (int)L; { const int q = nwg / NXCD, r = nwg % NXCD, xcd = wgid % NXCD, off = wgid / NXCD; wgid = (xcd < r ? xcd * (q + 1) : r * (q + 1) + (xcd - r) * q) + off; }
        const int nig = WGM * nN, gid = wgid / nig, fm = gid * WGM, gsz = (nM - fm) < WGM ? (nM - fm) : WGM;
        u.pm = fm + ((wgid % nig) % gsz); u.pn = (wgid % nig) / gsz; u.kofs = 0; u.nt = nt; u.slab = -1; return true;
    }
    __device__ __forceinline__ void a_ready(const Unit&) const {}
    __device__ __forceinline__ void done(const Unit&) const {}
};
__device__ __forceinline__ unsigned cvt_pk_bf16(float lo, float hi) { unsigned r; asm volatile("v_cvt_pk_bf16_f32 %0, %1, %2" : "=v"(r) : "v"(lo), "v"(hi)); return r; }

constexpr int TP_ROWS = 16384;
typedef unsigned u32x2 __attribute__((ext_vector_type(2)));
struct EpiG1 {
    static constexpr bool PERM = true, AFTER_DRAIN = false;
    bf16_t* Z; bf16_t* XBC;
    __device__ __forceinline__ void operator()(const f32x4 (&acc)[2][2][4][2], const Unit& u, int wr, int wc, int fr, int fq) const {
        const int row0 = u.pm * BM + wr * 64 + fr; const int colt = u.pn * BM;
        const bool isx = colt >= 2048;
        bf16_t* base = isx ? XBC : Z; const int ldc = isx ? 4096 : 2048; const int col0 = (isx ? colt - 2048 : colt) + wc * 32 + 8 * fq;
#pragma unroll
        for (int ai = 0; ai < 2; ++ai)
#pragma unroll
            for (int m = 0; m < 4; ++m) { bf16_t* rowp = base + (size_t)(row0 + ai * HALF + m * 16) * ldc + col0;
#pragma unroll
                for (int bj = 0; bj < 2; ++bj) { const f32x4 v0 = acc[ai][bj][m][0], v1 = acc[ai][bj][m][1];
                    u32x4 w; w.x = cvt_pk_bf16(v0[0], v0[1]); w.y = cvt_pk_bf16(v0[2], v0[3]); w.z = cvt_pk_bf16(v1[0], v1[1]); w.w = cvt_pk_bf16(v1[2], v1[3]);
                    *(u32x4*)(rowp + bj * HALF) = w; } }
    }
};
__device__ __forceinline__ float act_relu2(float v) { const float r = v > 0.f ? v : 0.f; return r * r; }
__device__ __forceinline__ float act_gelu_tanh(float v) { const float u = 0.7978845608f * (v + 0.044715f * v * v * v); return v * __builtin_amdgcn_rcpf(1.0f + __expf(-2.0f * u)); }
template <int ACT> struct EpiAct {
    static constexpr bool PERM = true, AFTER_DRAIN = false;
    bf16_t* O; int ldc; const float* bias;
    __device__ __forceinline__ void operator()(const f32x4 (&acc)[2][2][4][2], const Unit& u, int wr, int wc, int fr, int fq) const {
        const int row0 = u.pm * BM + wr * 64 + fr; const int col0 = u.pn * BM + wc * 32 + 8 * fq;
        f32x4 bv[2][2];
#pragma unroll
        for (int bj = 0; bj < 2; ++bj)
#pragma unroll
            for (int n = 0; n < 2; ++n) bv[bj][n] = (ACT == 2) ? *(const f32x4*)(bias + col0 + bj * HALF + 4 * n) : (f32x4){0.f, 0.f, 0.f, 0.f};
#pragma unroll
        for (int ai = 0; ai < 2; ++ai)
#pragma unroll
            for (int m = 0; m < 4; ++m) { bf16_t* rowp = O + (size_t)(row0 + ai * HALF + m * 16) * ldc + col0;
#pragma unroll
                for (int bj = 0; bj < 2; ++bj) { f32x4 v0 = acc[ai][bj][m][0] + bv[bj][0], v1 = acc[ai][bj][m][1] + bv[bj][1];
#pragma unroll
                    for (int j = 0; j < 4; ++j) { if (ACT == 1) { v0[j] = act_relu2(v0[j]); v1[j] = act_relu2(v1[j]); } else { v0[j] = act_gelu_tanh(v0[j]); v1[j] = act_gelu_tanh(v1[j]); } }
                    u32x4 w; w.x = cvt_pk_bf16(v0[0], v0[1]); w.y = cvt_pk_bf16(v0[2], v0[3]); w.z = cvt_pk_bf16(v1[0], v1[1]); w.w = cvt_pk_bf16(v1[2], v1[3]);
                    *(u32x4*)(rowp + bj * HALF) = w; } }
    }
};
struct EpiRes {
    static constexpr bool PERM = false, AFTER_DRAIN = false;
    const float* resP; const float* resS; float* out; float alpha; bf16_t* slabs;
    __device__ __forceinline__ void operator()(const f32x4 (&acc)[2][2][4][2], const Unit& u, int wr, int wc, int fr, int fq) const {
        if (u.slab >= 0) { bf16_t* sp = slabs + (size_t)u.slab * 65536 + (wr * 64 + fr) * 256 + wc * 32 + 4 * fq;
#pragma unroll
            for (int ai = 0; ai < 2; ++ai)
#pragma unroll
                for (int m = 0; m < 4; ++m)
#pragma unroll
                    for (int bj = 0; bj < 2; ++bj)
#pragma unroll
                        for (int n = 0; n < 2; ++n) { const f32x4 v = acc[ai][bj][m][n]; u32x2 w; w.x = cvt_pk_bf16(v[0], v[1]); w.y = cvt_pk_bf16(v[2], v[3]); *(u32x2*)(sp + (ai * HALF + m * 16) * 256 + bj * HALF + n * 16) = w; }
            return; }
        const int row0 = u.pm * BM + wr * 64 + fr, col0 = u.pn * BM + wc * 32 + 4 * fq;
#pragma unroll
        for (int ai = 0; ai < 2; ++ai)
#pragma unroll
            for (int m = 0; m < 4; ++m) { const int row = row0 + ai * HALF + m * 16;
                const float* rp = (row < TP_ROWS ? resP + (size_t)row * 1024 : resS + (size_t)(row - TP_ROWS) * 1024) + col0; float* op = out + (size_t)row * 1024 + col0;
#pragma unroll
                for (int bj = 0; bj < 2; ++bj)
#pragma unroll
                    for (int n = 0; n < 2; ++n) { const f32x4 r = *(const f32x4*)(rp + bj * HALF + n * 16); *(f32x4*)(op + bj * HALF + n * 16) = r * alpha + acc[ai][bj][m][n]; } }
    }
};
struct SplitOrder {
    StaticOrder so; int K, c;
    __device__ void init(int G_, int c_, int K_) { so.init(TP_ROWS, 1024, G_, c_, K_); K = K_; c = c_; }
    __device__ bool next(int i, Unit& u) const {
        if (i == 0) return so.next(0, u);
        if (i == 1 && c < 128) { u.pm = 64 + (c >> 4); u.pn = (c >> 2) & 3; u.kofs = (c & 3) * (K >> 2); u.nt = K >> 8; u.slab = c; return true; }
        return false; }
    __device__ __forceinline__ void a_ready(const Unit&) const {}
    __device__ __forceinline__ void done(const Unit&) const {}
};
template <class Epi, class Sched, bool ALIGN_EPI = false, bool SP2 = false>
__device__ __forceinline__ void gemm_phase(PG8_LAS unsigned char* lds, const Gemm g, const Sched& S, const Epi& E) {
    const int tid = threadIdx.x, wid = __builtin_amdgcn_readfirstlane(tid >> 6), lane = tid & 63, wr = wid >> 2, wc = wid & 3, fr = lane & 15, fq = lane >> 4;
    const int K = g.K;
    unsigned voffA[2], voffB[2];
#pragma unroll
    for (int i = 0; i < 2; ++i) { int R, C; stage_rc(tid * 16 + i * 8192, R, C); const int Rb = Epi::PERM ? ((R & ~31) + perm32(R & 31)) : R;
        voffA[i] = (unsigned)(R * g.lda + C) * 2u; voffB[i] = (unsigned)(Rb * K + C) * 2u; }
    const size_t kstep = (size_t)(BK * 2);
    const size_t hstepA = (size_t)HALF * g.lda * 2, hstepB = (size_t)HALF * K * 2;
    const size_t tstepA = 2 * hstepA, tstepB = 2 * hstepB;
    const unsigned ldsw = (unsigned)wid * 1024u;
    const int aoff = lds_byte(wr * 64 + fr, fq * 8), boff = lds_byte(wc * 32 + fr, fq * 8);
#define PG8_SA(b, h) (((b) * 2 + (h)) * HTB)
#define PG8_SB(b, h) ((4 + (b) * 2 + (h)) * HTB)
#define PG8_STAGE(bufoff, gbase, voff) do { _Pragma("unroll") for (int _i = 0; _i < 2; ++_i) \
        __builtin_amdgcn_global_load_lds((const unsigned*)((const char*)(gbase) + (voff)[_i]), (PG8_LAS unsigned*)(lds + (bufoff) + ldsw + _i * 8192), 16, 0, 0); } while (0)
#define PG8_LDA(dst, b, h) do { _Pragma("unroll") for (int m = 0; m < 4; ++m) _Pragma("unroll") for (int k = 0; k < 2; ++k) dst[m][k] = *(const PG8_LAS bf16x8*)(lds + PG8_SA(b, h) + aoff + m * 2048 + k * 1024); } while (0)
#define PG8_LDB(dst, b, h) do { _Pragma("unroll") for (int n = 0; n < 2; ++n) _Pragma("unroll") for (int k = 0; k < 2; ++k) dst[n][k] = *(const PG8_LAS bf16x8*)(lds + PG8_SB(b, h) + boff + n * 2048 + k * 1024); } while (0)
#define PG8_MMA(ai, bj, At, Bt) do { __builtin_amdgcn_s_setprio(1); _Pragma("unroll") for (int m = 0; m < 4; ++m) _Pragma("unroll") for (int n = 0; n < 2; ++n) _Pragma("unroll") for (int k = 0; k < 2; ++k) \
        acc[ai][bj][m][n] = __builtin_amdgcn_mfma_f32_16x16x32_bf16(Bt[n][k], At[m][k], acc[ai][bj][m][n], 0, 0, 0); __builtin_amdgcn_s_setprio(0); } while (0)
#define PG8_WAIT_V(n) asm volatile("s_waitcnt vmcnt(" #n ")" ::: "memory")
#define PG8_WAIT_L(n) asm volatile("s_waitcnt lgkmcnt(" #n ")" ::: "memory")
#define PG8_BAR __builtin_amdgcn_s_barrier()
#define PG8_SCHED __builtin_amdgcn_sched_barrier(0)
    Unit cur, nxt; int ui = 0;
    if (!S.next(0, cur)) return;
    f32x4 acc[2][2][4][2];
#pragma unroll
    for (int a = 0; a < 2; ++a)
#pragma unroll
        for (int b = 0; b < 2; ++b)
#pragma unroll
            for (int m = 0; m < 4; ++m)
#pragma unroll
                for (int n = 0; n < 2; ++n) acc[a][b][m][n] = (f32x4){0.f, 0.f, 0.f, 0.f};
    bf16x8 At[4][2], B0[2][2], B1[2][2];
    const char* cA = (const char*)g.A + (size_t)cur.pm * tstepA + (size_t)cur.kofs * 2; const char* cB = (const char*)g.Bt + (size_t)cur.pn * tstepB + (size_t)cur.kofs * 2;
    S.a_ready(cur);
    if constexpr (SP2) {
        PG8_STAGE(PG8_SB(0, 0), cB, voffB); PG8_STAGE(PG8_SB(0, 1), cB + hstepB, voffB); PG8_STAGE(PG8_SA(0, 0), cA, voffA); PG8_STAGE(PG8_SA(0, 1), cA + hstepA, voffA);
        if (wr == 1) PG8_BAR;
        PG8_WAIT_V(2); PG8_BAR;
        PG8_STAGE(PG8_SB(1, 0), cB + kstep, voffB); PG8_STAGE(PG8_SA(1, 0), cA + kstep, voffA); PG8_STAGE(PG8_SB(1, 1), cB + hstepB + kstep, voffB);
        PG8_WAIT_V(6); PG8_BAR;
    } else {
        PG8_STAGE(PG8_SB(0, 0), cB, voffB); PG8_STAGE(PG8_SA(0, 0), cA, voffA); PG8_STAGE(PG8_SB(0, 1), cB + hstepB, voffB); PG8_STAGE(PG8_SA(0, 1), cA + hstepA, voffA);
        if (wr == 1) PG8_BAR;
        PG8_WAIT_V(4); PG8_BAR;
        PG8_STAGE(PG8_SB(1, 0), cB + kstep, voffB); PG8_STAGE(PG8_SA(1, 0), cA + kstep, voffA); PG8_STAGE(PG8_SB(1, 1), cB + hstepB + kstep, voffB);
        PG8_WAIT_V(6); PG8_BAR;
    }
    for (;;) {
        const bool has_next = S.next(ui + 1, nxt);
        const char* nA = has_next ? (const char*)g.A + (size_t)nxt.pm * tstepA + (size_t)nxt.kofs * 2 : cA; const char* nB = has_next ? (const char*)g.Bt + (size_t)nxt.pn * tstepB + (size_t)nxt.kofs * 2 : cB;
        const int nt = cur.nt;
        for (int t = 0; t < nt; t += 2) {
            const bool last = (t == nt - 2);
            const char* a1 = cA + (size_t)(t + 1) * kstep;
            const char* a2 = last ? nA : cA + (size_t)(t + 2) * kstep; const char* b2 = last ? nB : cB + (size_t)(t + 2) * kstep;
            const char* a3 = a2 + kstep; const char* b3 = b2 + kstep;
            if (last && has_next) S.a_ready(nxt);
            if constexpr (SP2) {
            PG8_LDB(B0, 0, 0); PG8_LDB(B1, 0, 1); PG8_SCHED; PG8_LDA(At, 0, 0); PG8_STAGE(PG8_SA(1, 1), a1 + hstepA, voffA);
            PG8_WAIT_V(8); PG8_WAIT_L(0); PG8_BAR; PG8_MMA(0, 0, At, B0); PG8_MMA(0, 1, At, B1); PG8_BAR; PG8_SCHED;
            PG8_LDA(At, 0, 1); PG8_STAGE(PG8_SB(0, 0), b2, voffB); PG8_STAGE(PG8_SB(0, 1), b2 + hstepB, voffB); PG8_STAGE(PG8_SA(0, 0), a2, voffA);
            PG8_WAIT_V(8); PG8_WAIT_L(0); PG8_BAR; PG8_MMA(1, 0, At, B0); PG8_MMA(1, 1, At, B1); PG8_BAR; PG8_SCHED;
            PG8_LDB(B0, 1, 0); PG8_LDB(B1, 1, 1); PG8_SCHED; PG8_LDA(At, 1, 0); PG8_STAGE(PG8_SA(0, 1), a2 + hstepA, voffA);
            PG8_WAIT_V(8); PG8_WAIT_L(0); PG8_BAR; PG8_MMA(0, 0, At, B0); PG8_MMA(0, 1, At, B1); PG8_BAR; PG8_SCHED;
            PG8_LDA(At, 1, 1); PG8_STAGE(PG8_SB(1, 0), b3, voffB); PG8_STAGE(PG8_SB(1, 1), b3 + hstepB, voffB); PG8_STAGE(PG8_SA(1, 0), a3, voffA);
            PG8_WAIT_V(8); PG8_WAIT_L(0); PG8_BAR; PG8_MMA(1, 0, At, B0); PG8_MMA(1, 1, At, B1); PG8_BAR; PG8_SCHED;
            } else {
            PG8_LDB(B0, 0, 0); PG8_SCHED; PG8_LDA(At, 0, 0); PG8_STAGE(PG8_SA(1, 1), a1 + hstepA, voffA);
            PG8_WAIT_L(8); PG8_BAR; PG8_WAIT_L(0); PG8_MMA(0, 0, At, B0); PG8_BAR; PG8_SCHED;
            PG8_LDB(B1, 0, 1); PG8_STAGE(PG8_SB(0, 0), b2, voffB);
            PG8_BAR; PG8_WAIT_L(0); PG8_MMA(0, 1, At, B1); PG8_BAR;
            PG8_LDA(At, 0, 1); PG8_STAGE(PG8_SA(0, 0), a2, voffA);
            PG8_BAR; PG8_WAIT_L(0); PG8_MMA(1, 0, At, B0); PG8_BAR; PG8_SCHED;
            PG8_STAGE(PG8_SB(0, 1), b2 + hstepB, voffB);
            PG8_WAIT_V(6); PG8_BAR; PG8_MMA(1, 1, At, B1); PG8_BAR;
            PG8_LDB(B0, 1, 0); PG8_SCHED; PG8_LDA(At, 1, 0); PG8_STAGE(PG8_SA(0, 1), a2 + hstepA, voffA);
            PG8_WAIT_L(8); PG8_BAR; PG8_WAIT_L(0); PG8_MMA(0, 0, At, B0); PG8_BAR; PG8_SCHED;
            PG8_LDB(B1, 1, 1); PG8_STAGE(PG8_SB(1, 0), b3, voffB);
            PG8_BAR; PG8_WAIT_L(0); PG8_MMA(0, 1, At, B1); PG8_BAR;
            PG8_LDA(At, 1, 1); PG8_STAGE(PG8_SA(1, 0), a3, voffA);
            PG8_BAR; PG8_WAIT_L(0); PG8_MMA(1, 0, At, B0); PG8_BAR; PG8_SCHED;
            PG8_STAGE(PG8_SB(1, 1), b3 + hstepB, voffB);
            PG8_WAIT_V(6); PG8_BAR; PG8_MMA(1, 1, At, B1); PG8_BAR;
            }
        }
        if constexpr (ALIGN_EPI) { if (wr == 0) PG8_BAR; }
        if constexpr (!Epi::AFTER_DRAIN) { E(acc, cur, wr, wc, fr, fq); S.done(cur); }
        if (!has_next) break;
#pragma unroll
        for (int a = 0; a < 2; ++a)
#pragma unroll
            for (int b = 0; b < 2; ++b)
#pragma unroll
                for (int m = 0; m < 4; ++m)
#pragma unroll
                    for (int n = 0; n < 2; ++n) acc[a][b][m][n] = (f32x4){0.f, 0.f, 0.f, 0.f};
        cur = nxt; cA = nA; cB = nB; ++ui;
        if constexpr (ALIGN_EPI) { if (wr == 1) PG8_BAR; }
    }
    PG8_WAIT_V(0);
    if constexpr (!ALIGN_EPI) { if (wr == 0) PG8_BAR; }
    PG8_BAR;
    if constexpr (Epi::AFTER_DRAIN) { E.fused(acc, cur, wr, wc, fr, fq, lds, wid, lane); S.done(cur); }
#undef PG8_SA
#undef PG8_SB
#undef PG8_STAGE
#undef PG8_LDA
#undef PG8_LDB
#undef PG8_MMA
#undef PG8_WAIT_V
#undef PG8_WAIT_L
#undef PG8_BAR
#undef PG8_SCHED
}
}

#define LAS __attribute__((address_space(3)))
typedef LAS unsigned char* ldsp;
using pg8::bf16_t; using pg8::bf16x8; using pg8::f32x4; using pg8::u32x4; using pg8::cvt_pk_bf16;
using pg8::u32x2;

#define XB_TMO      128
#define XB_XCNT(j)  (256  + 64 * (j))
#define XB_XSUB(j)  (1280 + 64 * (j))
#define XB_XGEN(j)  (2304 + 64 * (j))
#define XB_TOP      3328
#define XB_TOPGEN   3392
#define XCD_BAR_WORDS 3456
#define XB_SPIN_CAP (1u << 18)

__device__ __forceinline__ unsigned xb_ld(unsigned* p)              { return __hip_atomic_load(p, __ATOMIC_RELAXED, __HIP_MEMORY_SCOPE_AGENT); }
__device__ __forceinline__ unsigned xb_add(unsigned* p, unsigned v) { return __hip_atomic_fetch_add(p, v, __ATOMIC_RELAXED, __HIP_MEMORY_SCOPE_AGENT); }
__device__ __forceinline__ unsigned xb_xcc_id() { return (unsigned)__builtin_amdgcn_s_getreg((3 << 11) | 20) & 0xFu; }
#define XB_SPIN(cond, bar) do { unsigned _sp = 0; while (cond) { __builtin_amdgcn_s_sleep(1); \
    if ((++_sp & 255u) == 0u) { if (xb_ld(&(bar)[XB_TMO])) break; if (_sp > XB_SPIN_CAP) { atomicAdd(&(bar)[XB_TMO], 1u); break; } } } } while (0)

struct XcdBarrier {
    unsigned* bar; unsigned x;
    volatile LAS unsigned* st;
};

__device__ __forceinline__ XcdBarrier xcd_barrier_post(unsigned* bar, volatile LAS unsigned* st) {
    XcdBarrier b; b.bar = bar; b.x = xb_xcc_id(); b.st = st;
    if (threadIdx.x == 0) (void)xb_add(&bar[XB_XCNT(b.x)], 1u);
    return b;
}
__device__ __forceinline__ void xcd_barrier_complete(unsigned* bar, unsigned x, unsigned& nloc, unsigned& nx) {
    const unsigned G = gridDim.x * gridDim.y * gridDim.z;
    unsigned sum, cnt, mine, sp = 0u;
    for (;;) {
        sum = 0u; cnt = 0u; mine = 0u;
#pragma unroll
        for (unsigned j = 0; j < 16; ++j) { const unsigned c = xb_ld(&bar[XB_XCNT(j)]); sum += c; cnt += (c > 0u) ? 1u : 0u; mine = (j == x) ? c : mine; }
        if (sum == G) break;
        __builtin_amdgcn_s_sleep(1);
        if ((++sp & 255u) == 0u) { if (xb_ld(&bar[XB_TMO])) break; if (sp > XB_SPIN_CAP) { atomicAdd(&bar[XB_TMO], 1u); break; } }
    }
    nloc = mine > 0u ? mine : 1u; nx = cnt > 0u ? cnt : 1u;
}

__device__ __forceinline__ void xcd_barrier(const XcdBarrier& b) {
    asm volatile("s_waitcnt vmcnt(0)" ::: "memory");
    __syncthreads();
    if (threadIdx.x == 0) {
        unsigned* bar = b.bar;
        __builtin_amdgcn_s_waitcnt(0);
        unsigned nloc = b.st[0], nx = b.st[1];
        if (nloc == 0u) { xcd_barrier_complete(bar, b.x, nloc, nx); b.st[0] = nloc; b.st[1] = nx; }
        const unsigned old = xb_add(&bar[XB_XSUB(b.x)], 1u);
        const unsigned gen = old / nloc;
        if (old + 1u == (gen + 1u) * nloc) {
            __builtin_amdgcn_fence(__ATOMIC_RELEASE, "agent");
            asm volatile("s_waitcnt vmcnt(0)" ::: "memory");
            const unsigned og = xb_add(&bar[XB_TOP], 1u);
            const unsigned tg = og / nx;
            if (og + 1u == (tg + 1u) * nx) xb_add(&bar[XB_TOPGEN], 1u);
            else XB_SPIN(xb_ld(&bar[XB_TOPGEN]) == tg, bar);
            __builtin_amdgcn_fence(__ATOMIC_ACQUIRE, "agent");
            xb_add(&bar[XB_XGEN(b.x)], 1u);
            asm volatile("s_waitcnt vmcnt(0)" ::: "memory");
        } else {
            XB_SPIN(xb_ld(&bar[XB_XGEN(b.x)]) == gen, bar);
            __builtin_amdgcn_fence(__ATOMIC_ACQUIRE, "agent");
            asm volatile("s_waitcnt vmcnt(0)" ::: "memory");
        }
    }
    __syncthreads();
}

constexpr int T = 18432, TP = 16384, DM = 1024;
constexpr float DN_ALPHA = 1.41421356237f;
constexpr float LN_EPS = 1e-5f;
constexpr size_t O_YP = 0, O_YS = 16777216, O_SSMP = 18874368, O_CONVP = 20971520, O_SSMS = 21069824, O_CONVS = 29458432, O_VROWS = 29851648;
constexpr size_t WS_XB = 0, WS_BIG = 37748736, WS_WOUT = 188743680, WS_W1 = 192937984, WS_W2 = 209715200, WS_CMWIN = 226492416, WS_CMWOUT = 234881024, WS_BAR = 239075328, WS_WIN = 239091712, WS_DT = 251740160, WS_END = 254099456;
constexpr size_t WS_SLAB = WS_WIN, WS_NEED = WS_SLAB + 16777216;
constexpr int LDS_BYTES = 149504, LDS_BARST = 149472;
constexpr int NPHASE = 17;

struct Params { const float* in[25]; float* out; unsigned char* ws; int ph_lo, ph_hi; };

__device__ __forceinline__ float bf_lo(unsigned w) { return __uint_as_float(w << 16); }
__device__ __forceinline__ float bf_hi(unsigned w) { return __uint_as_float(w & 0xffff0000u); }
__device__ __forceinline__ unsigned short f2bf(float f) { unsigned u = __float_as_uint(f); u += 0x7FFFu + ((u >> 16) & 1u); return (unsigned short)(u >> 16); }
__device__ __forceinline__ float silu_f(float x) { return x * __builtin_amdgcn_rcpf(1.0f + __expf(-x)); }
__device__ __forceinline__ float wave_sum(float v) {
#pragma unroll
    for (int o = 32; o >= 1; o >>= 1) v += __shfl_xor(v, o);
    return v;
}
__device__ __forceinline__ f32x4 mfma16(bf16x8 a, bf16x8 b, f32x4 c) { return __builtin_amdgcn_mfma_f32_16x16x32_bf16(a, b, c, 0, 0, 0); }

__device__ __forceinline__ void transpose_cvt(const float* __restrict__ W, int K, int N, bf16_t* __restrict__ WT, ldsp lds) {
    LAS float* tile = (LAS float*)lds;
    const int tid = threadIdx.x; const int ntn = (N + 63) / 64, ntiles = (K / 64) * ntn;
    for (int t = blockIdx.x; t < ntiles; t += gridDim.x) {
        const int k0 = (t / ntn) * 64, n0 = (t % ntn) * 64;
#pragma unroll
        for (int i = 0; i < 8; ++i) { const int k = (tid >> 6) + 8 * i, n = tid & 63; tile[k * 65 + n] = (n0 + n < N) ? W[(size_t)(k0 + k) * N + n0 + n] : 0.f; }
        __syncthreads();
#pragma unroll
        for (int i = 0; i < 4; ++i) { const int kp = 2 * (tid & 31), nn = (tid >> 5) + 16 * i;
            if (n0 + nn < N) *(unsigned*)(WT + (size_t)(n0 + nn) * K + k0 + kp) = cvt_pk_bf16(tile[kp * 65 + nn], tile[(kp + 1) * 65 + nn]); }
        __syncthreads();
    }
}
__device__ __forceinline__ void phase_prep(const Params& p, ldsp lds) {
    unsigned char* ws = p.ws;
    transpose_cvt(p.in[4], 1024, 6176, (bf16_t*)(ws + WS_WIN), lds);
    transpose_cvt(p.in[11], 2048, 1024, (bf16_t*)(ws + WS_WOUT), lds);
    transpose_cvt(p.in[19], 1024, 4096, (bf16_t*)(ws + WS_W1), lds);
    transpose_cvt(p.in[19] + (size_t)1024 * 4096, 1024, 4096, (bf16_t*)(ws + WS_W1) + (size_t)4096 * 1024, lds);
    transpose_cvt(p.in[20], 4096, 1024, (bf16_t*)(ws + WS_W2), lds);
    transpose_cvt(p.in[20] + (size_t)4096 * 1024, 4096, 1024, (bf16_t*)(ws + WS_W2) + (size_t)4096 * 1024, lds);
    transpose_cvt(p.in[12], 1024, 4096, (bf16_t*)(ws + WS_CMWIN), lds);
    transpose_cvt(p.in[18], 2048, 1024, (bf16_t*)(ws + WS_CMWOUT), lds);
    const f32x4* xp = (const f32x4*)p.in[0]; const f32x4* xs = (const f32x4*)p.in[1]; u32x2* xb = (u32x2*)(ws + WS_XB);
    const int n4p = TP * DM / 4, n4 = T * DM / 4;
    for (int i = blockIdx.x * 512 + threadIdx.x; i < n4; i += gridDim.x * 512) { const f32x4 v = (i < n4p) ? xp[i] : xs[i - n4p]; u32x2 w; w.x = cvt_pk_bf16(v[0], v[1]); w.y = cvt_pk_bf16(v[2], v[3]); xb[i] = w; }
}

__device__ __forceinline__ void phase_dt(const Params& p) {
    const int tid = threadIdx.x, wid = tid >> 6, lane = tid & 63;
    const bf16_t* XB = (const bf16_t*)(p.ws + WS_XB); const bf16_t* WT = (const bf16_t*)(p.ws + WS_WIN) + (size_t)6144 * 1024; float* DT = (float*)(p.ws + WS_DT);
    const float* bias = p.in[7];
    for (int tile = blockIdx.x * 8 + wid; tile < T / 16; tile += gridDim.x * 8) {
        f32x4 a0 = {0.f, 0.f, 0.f, 0.f}, a1 = {0.f, 0.f, 0.f, 0.f};
        const bf16_t* ap = XB + (size_t)(tile * 16 + (lane & 15)) * 1024 + 8 * (lane >> 4);
        const bf16_t* bp0 = WT + (size_t)(lane & 15) * 1024 + 8 * (lane >> 4); const bf16_t* bp1 = bp0 + 16 * 1024;
#pragma unroll 4
        for (int kk = 0; kk < 32; ++kk) { const bf16x8 a = *(const bf16x8*)(ap + kk * 32), b0 = *(const bf16x8*)(bp0 + kk * 32), b1 = *(const bf16x8*)(bp1 + kk * 32); a0 = mfma16(a, b0, a0); a1 = mfma16(a, b1, a1); }
        const int hd = lane & 15; const float bb0 = bias[hd], bb1 = bias[16 + hd];
#pragma unroll
        for (int r = 0; r < 4; ++r) { const int tok = tile * 16 + (lane >> 4) * 4 + r; const float x0 = a0[r] + bb0, x1 = a1[r] + bb1;
            DT[(size_t)tok * 32 + hd] = x0 > 20.f ? x0 : log1pf(__expf(x0)); DT[(size_t)tok * 32 + 16 + hd] = x1 > 20.f ? x1 : log1pf(__expf(x1)); }
    }
}

constexpr int N_CS = 0, N_BS = 17408, N_BT = 34816, N_XDT = 53248, N_XW = 62464, N_XS = 71680, N_HB = 80896, N_WP = 98304, N_DTS = 116736, N_ACS = 116992, N_CW = 117248;
constexpr int ST128 = 272, ST64 = 144;
__device__ __forceinline__ int scan_chan(int j0, int h, int g) { return j0 < 64 ? h * 64 + j0 : (j0 < 192 ? 2048 + g * 128 + (j0 - 64) : 3072 + g * 128 + (j0 - 192)); }
__device__ __forceinline__ int tsw(int row, int slot) { return row * ST64 + ((slot ^ ((row >> 3) & 7)) << 4); }
__device__ __forceinline__ float rdlane(float v, int l) { return __int_as_float(__builtin_amdgcn_readlane(__float_as_int(v), l)); }
template <bool DUMMY> __device__ __forceinline__ void phase_scan(const Params& p, ldsp lds) {
    const int tid = threadIdx.x, wid = __builtin_amdgcn_readfirstlane(tid >> 6), lane0 = tid & 63, lane = lane0, fr = lane & 15, fq = lane >> 4;
    const int ti = wid >> 1, half = wid & 1, hp = ti;
    const bool cl = lane < 40;
    const bf16_t* XBC = (const bf16_t*)(p.ws + WS_BIG); bf16_t* Z = (bf16_t*)p.out; const float* DT = (const float*)(p.ws + WS_DT);
    LAS float* dts = (LAS float*)(lds + N_DTS); LAS float* acs = (LAS float*)(lds + N_ACS);
    ldsp wp = lds + N_WP + wid * 2304;
    for (int chain = blockIdx.x; chain < 1280; chain += gridDim.x) {
        int b, h, nsteps, row0; const float* h0 = nullptr; const float* cprev = nullptr; float* hout; float* cdst;
        if (chain < 256) { b = chain >> 5; h = chain & 31; nsteps = 32; row0 = b * 2048; hout = p.out + O_SSMP + (size_t)(b * 32 + h) * 8192; cdst = p.out + O_CONVP + (size_t)b * 3 * 4096; }
        else { const int i = chain - 256; b = i >> 5; h = i & 31; nsteps = 1; row0 = TP + b * 64; h0 = p.in[2] + (size_t)(b * 32 + h) * 8192; cprev = p.in[3] + (size_t)b * 3 * 4096; hout = p.out + O_SSMS + (size_t)(b * 32 + h) * 8192; cdst = p.out + O_CONVS + (size_t)b * 3 * 4096; }
        const int g = h >> 2; const float A_h = -__expf(p.in[8][h]), D_h = p.in[9][h];
        const int ch0 = scan_chan(cl ? 8 * lane : 0, h, g);
        for (int idx = tid; idx < 1600; idx += 512) { const int k = idx / 320, j = idx % 320, ch = scan_chan(j, h, g); ((LAS float*)(lds + N_CW))[idx] = k < 4 ? p.in[5][k * 4096 + ch] : p.in[6][ch]; }
        f32x4 hacc[4];
#pragma unroll
        for (int q = 0; q < 4; ++q)
#pragma unroll
            for (int r = 0; r < 4; ++r) { const int pp = hp * 16 + 4 * fq + r, n = (4 * half + q) * 16 + fr; const float v = h0 ? h0[pp * 128 + n] : 0.f; hacc[q][r] = v;
                *(LAS unsigned short*)(lds + N_HB + pp * ST128 + n * 2) = f2bf(v); }
        u32x4 raw[11]; u32x4 zr; float dtv;
#define SCAN_PREFETCH(s_) do { const int Rn_ = row0 + 64 * (s_); \
            if (cl) { _Pragma("unroll") for (int i = 0; i < 11; ++i) { const int rr = 8 * wid - 3 + i; \
                if (rr >= 0 || (s_) > 0) raw[i] = *(const u32x4*)(XBC + (size_t)(Rn_ + rr) * 4096 + ch0); \
                else if (cprev) { const f32x4 c0 = *(const f32x4*)(cprev + (3 + rr) * 4096 + ch0), c1 = *(const f32x4*)(cprev + (3 + rr) * 4096 + ch0 + 4); \
                    raw[i].x = cvt_pk_bf16(c0[0], c0[1]); raw[i].y = cvt_pk_bf16(c0[2], c0[3]); raw[i].z = cvt_pk_bf16(c1[0], c1[1]); raw[i].w = cvt_pk_bf16(c1[2], c1[3]); } \
                else raw[i] = (u32x4){0u, 0u, 0u, 0u}; } } \
            zr = *(const u32x4*)(Z + (size_t)(Rn_ + 16 * ti + (lane >> 2)) * 2048 + h * 64 + 32 * half + (lane & 3) * 8); \
            dtv = DT[(size_t)(Rn_ + lane) * 32 + h]; } while (0)
#pragma unroll
        for (int i = 0; i < 11; ++i) raw[i] = (u32x4){0u, 0u, 0u, 0u};
        SCAN_PREFETCH(0);
        for (int step = 0; step < nsteps; ++step) {
            const int R = row0 + step * 64;
            int lane_o = lane0; asm volatile("" : "+v"(lane_o));
            const int lane = lane_o, fr = lane & 15, fq = lane >> 4;
            float ac = dtv * A_h;
#pragma unroll
            for (int d = 1; d < 64; d <<= 1) { const float n = __shfl_up(ac, d); if (lane >= d) ac += n; }
            dts[lane] = dtv; acs[lane] = ac;
            const float a_last = rdlane(ac, 63);
            if (step == nsteps - 1 && wid == 7 && cl && (lane < 8 || (h & 3) == 0)) {
#pragma unroll
                for (int k = 0; k < 3; ++k) { const u32x4 r = raw[8 + k]; float* d = cdst + k * 4096 + ch0;
                    *(f32x4*)d = (f32x4){bf_lo(r.x), bf_hi(r.x), bf_lo(r.y), bf_hi(r.y)}; *(f32x4*)(d + 4) = (f32x4){bf_lo(r.z), bf_hi(r.z), bf_lo(r.w), bf_hi(r.w)}; } }
            if (cl) {
                const int rmbase = lane < 8 ? N_XS + lane * 16 : (lane < 24 ? N_BS + (lane - 8) * 16 : N_CS + (lane - 24) * 16); const int rmst = lane < 8 ? ST64 : ST128;
                const int trbase = lane < 8 ? N_XDT : N_BT; const int trrow = lane < 8 ? 8 * lane : 8 * (lane - 8);
#pragma unroll
                for (int hh = 0; hh < 2; ++hh) {
                    float o[4][8]; float cwt[4][8];
                    { const LAS float* cwp = (const LAS float*)(lds + N_CW) + 8 * lane;
#pragma unroll
                        for (int k = 0; k < 4; ++k) { const f32x4 a0 = *(const LAS f32x4*)(cwp + k * 320), a1 = *(const LAS f32x4*)(cwp + k * 320 + 4);
#pragma unroll
                            for (int e = 0; e < 4; ++e) { cwt[k][e] = a0[e]; cwt[k][4 + e] = a1[e]; } }
                        const f32x4 b0 = *(const LAS f32x4*)(cwp + 4 * 320), b1 = *(const LAS f32x4*)(cwp + 4 * 320 + 4);
#pragma unroll
                        for (int j = 0; j < 4; ++j)
#pragma unroll
                            for (int e = 0; e < 4; ++e) { o[j][e] = b0[e]; o[j][4 + e] = b1[e]; } }
#pragma unroll
                    for (int i = 0; i < 7; ++i) { const u32x4 r = raw[4 * hh + i];
                        const float x[8] = {bf_lo(r.x), bf_hi(r.x), bf_lo(r.y), bf_hi(r.y), bf_lo(r.z), bf_hi(r.z), bf_lo(r.w), bf_hi(r.w)};
#pragma unroll
                        for (int j = 0; j < 4; ++j) { const int k = i - j; if (k >= 0 && k < 4) {
#pragma unroll
                            for (int e = 0; e < 8; ++e) o[j][e] += cwt[k][e] * x[e]; } } }
                    float s1[4], s2[4];
#pragma unroll
                    for (int j = 0; j < 4; ++j) { const int t = 8 * wid + 4 * hh + j;
#pragma unroll
                        for (int e = 0; e < 8; ++e) o[j][e] = silu_f(o[j][e]);
                        u32x4 w; w.x = cvt_pk_bf16(o[j][0], o[j][1]); w.y = cvt_pk_bf16(o[j][2], o[j][3]); w.z = cvt_pk_bf16(o[j][4], o[j][5]); w.w = cvt_pk_bf16(o[j][6], o[j][7]);
                        *(LAS u32x4*)(lds + rmbase + t * rmst) = w;
                        const float dtt = rdlane(dtv, t), act = rdlane(ac, t); s1[j] = lane < 8 ? dtt : 1.0f; s2[j] = dtt * __expf(a_last - act); }
                    if (lane < 24) {
#pragma unroll
                        for (int e = 0; e < 8; ++e) { u32x2 v; v.x = cvt_pk_bf16(o[0][e] * s1[0], o[1][e] * s1[1]); v.y = cvt_pk_bf16(o[2][e] * s1[2], o[3][e] * s1[3]);
                            *(LAS u32x2*)(lds + trbase + tsw(trrow + e, wid) + hh * 8) = v; }
                        if (lane < 8) {
#pragma unroll
                            for (int e = 0; e < 8; ++e) { u32x2 v; v.x = cvt_pk_bf16(o[0][e] * s2[0], o[1][e] * s2[1]); v.y = cvt_pk_bf16(o[2][e] * s2[2], o[3][e] * s2[3]);
                                *(LAS u32x2*)(lds + N_XW + tsw(trrow + e, wid) + hh * 8) = v; } } }
                }
            }
            const u32x4 zcur = zr;
            asm volatile("" ::: "memory"); __builtin_amdgcn_sched_barrier(0);
            if (step + 1 < nsteps) SCAN_PREFETCH(step + 1);
            asm volatile("" ::: "memory"); __builtin_amdgcn_sched_barrier(0);
            __syncthreads();
            f32x4 yacc[2];
            { bf16x8 af[4];
#pragma unroll
                for (int kk = 0; kk < 4; ++kk) af[kk] = *(const LAS bf16x8*)(lds + N_CS + (ti * 16 + fr) * ST128 + (kk * 32 + 8 * fq) * 2);
                float act[4];
#pragma unroll
                for (int r = 0; r < 4; ++r) act[r] = acs[ti * 16 + 4 * fq + r];
#pragma unroll
                for (int si = 0; si < 4; ++si) {
                    if (si <= ti) { f32x4 cb = {0.f, 0.f, 0.f, 0.f};
#pragma unroll
                        for (int kk = 0; kk < 4; ++kk) cb = mfma16(af[kk], *(const LAS bf16x8*)(lds + N_BS + (si * 16 + fr) * ST128 + (kk * 32 + 8 * fq) * 2), cb);
                        const int s = si * 16 + fr; const float as = acs[s];
#pragma unroll
                        for (int r = 0; r < 4; ++r) { const int t = ti * 16 + 4 * fq + r; const float mv = (s <= t) ? cb[r] * __expf(act[r] - as) : 0.f; *(LAS unsigned short*)(wp + (4 * fq + r) * ST64 + s * 2) = f2bf(mv); } }
                    else if (si == (ti | 1)) {
#pragma unroll
                        for (int r = 0; r < 4; ++r) *(LAS unsigned short*)(wp + (4 * fq + r) * ST64 + (si * 16 + fr) * 2) = (unsigned short)0; } }
#pragma unroll
                for (int q = 0; q < 2; ++q) { const int pi = 2 * half + q; f32x4 y = {0.f, 0.f, 0.f, 0.f};
#pragma unroll
                    for (int kk = 0; kk < 4; ++kk) y = mfma16(af[kk], *(const LAS bf16x8*)(lds + N_HB + (pi * 16 + fr) * ST128 + (kk * 32 + 8 * fq) * 2), y);
#pragma unroll
                    for (int r = 0; r < 4; ++r) y[r] *= __expf(act[r]);
                    yacc[q] = y; } }
            __syncthreads();
            {
#pragma unroll
                for (int q = 0; q < 2; ++q) { const int pi = 2 * half + q;
#pragma unroll
                    for (int kk = 0; kk < 2; ++kk) if (2 * kk <= ti) yacc[q] = mfma16(*(const LAS bf16x8*)(wp + fr * ST64 + (kk * 32 + 8 * fq) * 2), *(const LAS bf16x8*)(lds + N_XDT + tsw(pi * 16 + fr, 4 * kk + fq)), yacc[q]); }
                const float ea = __expf(a_last);
                bf16x8 xa[2];
#pragma unroll
                for (int kk = 0; kk < 2; ++kk) xa[kk] = *(const LAS bf16x8*)(lds + N_XW + tsw(hp * 16 + fr, 4 * kk + fq));
#pragma unroll
                for (int q = 0; q < 4; ++q) { const int ni = 4 * half + q; f32x4 hv = hacc[q] * ea;
#pragma unroll
                    for (int kk = 0; kk < 2; ++kk) hv = mfma16(xa[kk], *(const LAS bf16x8*)(lds + N_BT + tsw(ni * 16 + fr, 4 * kk + fq)), hv);
                    hacc[q] = hv;
#pragma unroll
                    for (int r = 0; r < 4; ++r) *(LAS unsigned short*)(lds + N_HB + (hp * 16 + 4 * fq + r) * ST128 + (ni * 16 + fr) * 2) = f2bf(hv[r]); }
                __builtin_amdgcn_wave_barrier();
#pragma unroll
                for (int q = 0; q < 2; ++q)
#pragma unroll
                    for (int r = 0; r < 4; ++r) *(LAS float*)(wp + (4 * fq + r) * 144 + (16 * q + fr) * 4) = yacc[q][r];
                __builtin_amdgcn_wave_barrier();
                const int tl = lane >> 2, pq = lane & 3;
                const f32x4 y0 = *(const LAS f32x4*)(wp + tl * 144 + pq * 32), y1 = *(const LAS f32x4*)(wp + tl * 144 + pq * 32 + 16);
                const u32x4 xr = *(const LAS u32x4*)(lds + N_XS + (16 * ti + tl) * ST64 + (32 * half + 8 * pq) * 2);
                const float xs[8] = {bf_lo(xr.x), bf_hi(xr.x), bf_lo(xr.y), bf_hi(xr.y), bf_lo(xr.z), bf_hi(xr.z), bf_lo(xr.w), bf_hi(xr.w)};
                const float zz[8] = {bf_lo(zcur.x), bf_hi(zcur.x), bf_lo(zcur.y), bf_hi(zcur.y), bf_lo(zcur.z), bf_hi(zcur.z), bf_lo(zcur.w), bf_hi(zcur.w)};
                float gg[8];
#pragma unroll
                for (int e = 0; e < 8; ++e) { const float yv = (e < 4 ? y0[e & 3] : y1[e & 3]) + D_h * xs[e]; gg[e] = yv * silu_f(zz[e]); }
                u32x4 w; w.x = cvt_pk_bf16(gg[0], gg[1]); w.y = cvt_pk_bf16(gg[2], gg[3]); w.z = cvt_pk_bf16(gg[4], gg[5]); w.w = cvt_pk_bf16(gg[6], gg[7]);
                if (DUMMY) *(u32x4*)((bf16_t*)(p.ws + WS_END) + (size_t)(blockIdx.x * 64 + 16 * ti + tl) * 64 + 32 * half + 8 * pq) = w;
                else *(u32x4*)(Z + (size_t)(R + 16 * ti + tl) * 2048 + h * 64 + 32 * half + 8 * pq) = w; }
            __syncthreads();
        }
#undef SCAN_PREFETCH
#pragma unroll
        for (int q = 0; q < 4; ++q)
#pragma unroll
            for (int r = 0; r < 4; ++r) hout[(hp * 16 + 4 * fq + r) * 128 + (4 * half + q) * 16 + fr] = hacc[q][r];
    }
}

__device__ __forceinline__ void phase_gnorm(const Params& p) {
    const int wid = threadIdx.x >> 6, lane = threadIdx.x & 63; bf16_t* Z = (bf16_t*)p.out; const float* nw = p.in[10];
    for (int row = blockIdx.x * 8 + wid; row < T; row += gridDim.x * 8) {
        bf16_t* zr = Z + (size_t)row * 2048 + 8 * lane;
        u32x4 raw[4];
#pragma unroll
        for (int j = 0; j < 4; ++j) raw[j] = *(const u32x4*)(zr + 512 * j);
#pragma unroll
        for (int j = 0; j < 4; ++j) { const float v[8] = {bf_lo(raw[j].x), bf_hi(raw[j].x), bf_lo(raw[j].y), bf_hi(raw[j].y), bf_lo(raw[j].z), bf_hi(raw[j].z), bf_lo(raw[j].w), bf_hi(raw[j].w)};
            float ss = 0.f;
#pragma unroll
            for (int e = 0; e < 8; ++e) ss += v[e] * v[e];
#pragma unroll
            for (int o = 16; o >= 1; o >>= 1) ss += __shfl_xor(ss, o);
            const float sc = rsqrtf(ss * (1.0f / 256.0f) + LN_EPS);
            const f32x4 w0 = *(const f32x4*)(nw + 512 * j + 8 * lane), w1 = *(const f32x4*)(nw + 512 * j + 8 * lane + 4);
            u32x4 w; w.x = cvt_pk_bf16(v[0] * sc * w0[0], v[1] * sc * w0[1]); w.y = cvt_pk_bf16(v[2] * sc * w0[2], v[3] * sc * w0[3]); w.z = cvt_pk_bf16(v[4] * sc * w1[0], v[5] * sc * w1[1]); w.w = cvt_pk_bf16(v[6] * sc * w1[2], v[7] * sc * w1[3]);
            *(u32x4*)(zr + 512 * j) = w; }
    }
}

__device__ __forceinline__ void phase_ln(const float* src, const float* resS, const bf16_t* slabs, float* dstf, bf16_t* dstb, const float* gam, const float* bet) {
    const int wid = threadIdx.x >> 6, lane = threadIdx.x & 63;
    f32x4 gv[4], bv[4];
#pragma unroll
    for (int j = 0; j < 4; ++j) { gv[j] = *(const f32x4*)(gam + 256 * j + 4 * lane); bv[j] = *(const f32x4*)(bet + 256 * j + 4 * lane); }
    for (int row = blockIdx.x * 8 + wid; row < T; row += gridDim.x * 8) {
        f32x4 v[4]; float sum = 0.f;
        if (row < TP) { const float* sp = src + (size_t)row * 1024 + 4 * lane;
#pragma unroll
            for (int j = 0; j < 4; ++j) v[j] = *(const f32x4*)(sp + 256 * j); }
        else { const int r = row - TP; const float* rp = resS + (size_t)r * 1024 + 4 * lane; const bf16_t* sl = slabs + (size_t)((r >> 8) * 16) * 65536 + (r & 255) * 256 + 4 * lane;
#pragma unroll
            for (int j = 0; j < 4; ++j) { f32x4 a = *(const f32x4*)(rp + 256 * j) * DN_ALPHA;
#pragma unroll
                for (int k = 0; k < 4; ++k) { const u32x2 w = *(const u32x2*)(sl + (size_t)(j * 4 + k) * 65536); a += (f32x4){bf_lo(w.x), bf_hi(w.x), bf_lo(w.y), bf_hi(w.y)}; }
                v[j] = a; } }
#pragma unroll
        for (int j = 0; j < 4; ++j) sum += (v[j][0] + v[j][1]) + (v[j][2] + v[j][3]);
        const float mean = wave_sum(sum) * (1.0f / 1024.0f); float q = 0.f;
#pragma unroll
        for (int j = 0; j < 4; ++j) { const f32x4 d = v[j] - mean; q += (d[0] * d[0] + d[1] * d[1]) + (d[2] * d[2] + d[3] * d[3]); }
        const float rstd = rsqrtf(wave_sum(q) * (1.0f / 1024.0f) + LN_EPS);
#pragma unroll
        for (int j = 0; j < 4; ++j) { const f32x4 o = (v[j] - mean) * rstd * gv[j] + bv[j];
            *(f32x4*)(dstf + (size_t)row * 1024 + 4 * lane + 256 * j) = o;
            if (dstb) { u32x2 w; w.x = cvt_pk_bf16(o[0], o[1]); w.y = cvt_pk_bf16(o[2], o[3]); *(u32x2*)(dstb + (size_t)row * 1024 + 4 * lane + 256 * j) = w; } }
    }
}

__device__ __forceinline__ void phase_lnv(const Params& p) {
    const int wid = threadIdx.x >> 6, lane = threadIdx.x & 63; bf16_t* BIG = (bf16_t*)(p.ws + WS_BIG); const float* gam = p.in[14]; const float* bet = p.in[15]; float* vrows = p.out + O_VROWS;
    for (int row = blockIdx.x * 8 + wid; row < T; row += gridDim.x * 8) {
        bf16_t* vr = BIG + (size_t)row * 4096 + 2048 + 8 * lane; float v[4][8]; float sum = 0.f;
#pragma unroll
        for (int j = 0; j < 4; ++j) { const u32x4 r = *(const u32x4*)(vr + 512 * j);
            v[j][0] = bf_lo(r.x); v[j][1] = bf_hi(r.x); v[j][2] = bf_lo(r.y); v[j][3] = bf_hi(r.y); v[j][4] = bf_lo(r.z); v[j][5] = bf_hi(r.z); v[j][6] = bf_lo(r.w); v[j][7] = bf_hi(r.w);
#pragma unroll
            for (int e = 0; e < 8; ++e) sum += v[j][e]; }
        const float mean = wave_sum(sum) * (1.0f / 2048.0f); float q = 0.f;
#pragma unroll
        for (int j = 0; j < 4; ++j)
#pragma unroll
            for (int e = 0; e < 8; ++e) { const float d = v[j][e] - mean; q += d * d; }
        const float rstd = rsqrtf(wave_sum(q) * (1.0f / 2048.0f) + LN_EPS);
#pragma unroll
        for (int j = 0; j < 4; ++j) { const int c = 512 * j + 8 * lane;
            const f32x4 g0 = *(const f32x4*)(gam + c), g1 = *(const f32x4*)(gam + c + 4), b0 = *(const f32x4*)(bet + c), b1 = *(const f32x4*)(bet + c + 4);
            f32x4 o0, o1;
#pragma unroll
            for (int e = 0; e < 4; ++e) { o0[e] = (v[j][e] - mean) * rstd * g0[e] + b0[e]; o1[e] = (v[j][4 + e] - mean) * rstd * g1[e] + b1[e]; }
            u32x4 w; w.x = cvt_pk_bf16(o0[0], o0[1]); w.y = cvt_pk_bf16(o0[2], o0[3]); w.z = cvt_pk_bf16(o1[0], o1[1]); w.w = cvt_pk_bf16(o1[2], o1[3]);
            *(u32x4*)(vr + 512 * j) = w;
            if (row >= TP) { float* d = vrows + (size_t)(row - TP) * 2048 + c; *(f32x4*)d = o0; *(f32x4*)(d + 4) = o1; } }
    }
}

constexpr int SP_VT = 0, SP_WS = 69632, SP_SO = 0, SP_VST = 272, SP_SOST = 528;
template <bool DUMMY> __device__ __forceinline__ void phase_spatial(const Params& p, ldsp lds) {
    const int tid = threadIdx.x, wid = tid >> 6, lane = tid & 63, fr = lane & 15, fq = lane >> 4;
    bf16_t* BIG = (bf16_t*)(p.ws + WS_BIG); const float* wsp = p.in[16]; const float* bsp = p.in[17];
    for (int unit = blockIdx.x; unit < 1280; unit += gridDim.x) {
        int R, L, g;
        if (unit < 1024) { g = unit & 7; R = (unit >> 3) * 128; L = 128; } else { const int i = unit - 1024; g = i & 7; R = TP + (i >> 3) * 64; L = 64; }
        for (int idx = tid; idx < L * 32; idx += 512) { const int s = idx >> 5, c8 = (idx & 31) * 8; const u32x4 r = *(const u32x4*)(BIG + (size_t)(R + s) * 4096 + 2048 + g * 256 + c8);
            const unsigned wv[4] = {r.x, r.y, r.z, r.w};
#pragma unroll
            for (int e = 0; e < 4; ++e) { *(LAS unsigned short*)(lds + SP_VT + (c8 + 2 * e) * SP_VST + s * 2) = (unsigned short)(wv[e] & 0xffffu); *(LAS unsigned short*)(lds + SP_VT + (c8 + 2 * e + 1) * SP_VST + s * 2) = (unsigned short)(wv[e] >> 16); } }
        for (int idx = tid; idx < L * (L / 4); idx += 512) { const int t = idx / (L / 4), s0 = (idx % (L / 4)) * 4; const f32x4 w = *(const f32x4*)(wsp + (size_t)(g * 128 + t) * 128 + s0);
            u32x2 o; o.x = cvt_pk_bf16(s0 <= t ? w[0] : 0.f, s0 + 1 <= t ? w[1] : 0.f); o.y = cvt_pk_bf16(s0 + 2 <= t ? w[2] : 0.f, s0 + 3 <= t ? w[3] : 0.f);
            *(LAS u32x2*)(lds + SP_WS + t * SP_VST + s0 * 2) = o; }
        __syncthreads();
        const int nT = L / 16, nK = L / 32;
        f32x4 acc[8][2];
#pragma unroll
        for (int ti = 0; ti < 8; ++ti) { acc[ti][0] = (f32x4){0.f, 0.f, 0.f, 0.f}; acc[ti][1] = (f32x4){0.f, 0.f, 0.f, 0.f}; }
#pragma unroll
        for (int kk = 0; kk < 4; ++kk) if (kk < nK) {
            const bf16x8 b0 = *(const LAS bf16x8*)(lds + SP_VT + (wid * 32 + fr) * SP_VST + (kk * 32 + 8 * fq) * 2), b1 = *(const LAS bf16x8*)(lds + SP_VT + (wid * 32 + 16 + fr) * SP_VST + (kk * 32 + 8 * fq) * 2);
#pragma unroll
            for (int ti = 0; ti < 8; ++ti) if (ti < nT && 32 * kk <= 16 * ti + 15) { const bf16x8 a = *(const LAS bf16x8*)(lds + SP_WS + (ti * 16 + fr) * SP_VST + (kk * 32 + 8 * fq) * 2);
                acc[ti][0] = mfma16(a, b0, acc[ti][0]); acc[ti][1] = mfma16(a, b1, acc[ti][1]); } }
        __syncthreads();
#pragma unroll
        for (int ti = 0; ti < 8; ++ti) if (ti < nT) {
#pragma unroll
            for (int r = 0; r < 4; ++r) { const int t = ti * 16 + 4 * fq + r; const float bb = bsp[g * 128 + t];
                *(LAS unsigned short*)(lds + SP_SO + t * SP_SOST + (wid * 32 + fr) * 2) = f2bf(acc[ti][0][r] + bb); *(LAS unsigned short*)(lds + SP_SO + t * SP_SOST + (wid * 32 + 16 + fr) * 2) = f2bf(acc[ti][1][r] + bb); } }
        __syncthreads();
        for (int idx = tid; idx < L * 32; idx += 512) { const int t = idx >> 5, c8 = (idx & 31) * 8; bf16_t* up = BIG + (size_t)(R + t) * 4096 + g * 256 + c8;
            const u32x4 uu = *(const u32x4*)up; const u32x4 ss = *(const LAS u32x4*)(lds + SP_SO + t * SP_SOST + c8 * 2);
            u32x4 w; w.x = cvt_pk_bf16(bf_lo(uu.x) * bf_lo(ss.x), bf_hi(uu.x) * bf_hi(ss.x)); w.y = cvt_pk_bf16(bf_lo(uu.y) * bf_lo(ss.y), bf_hi(uu.y) * bf_hi(ss.y));
            w.z = cvt_pk_bf16(bf_lo(uu.z) * bf_lo(ss.z), bf_hi(uu.z) * bf_hi(ss.z)); w.w = cvt_pk_bf16(bf_lo(uu.w) * bf_lo(ss.w), bf_hi(uu.w) * bf_hi(ss.w));
            if (DUMMY) *(u32x4*)((bf16_t*)(p.ws + WS_END) + (size_t)blockIdx.x * 16384 + (t & 63) * 256 + c8) = w; else *(u32x4*)up = w; }
        __syncthreads();
    }
}

__global__ void __launch_bounds__(512, 2) fwd_kernel(Params p) {
    extern __shared__ __attribute__((aligned(16))) unsigned char smem[];
    ldsp lds = (ldsp)smem;
    cg::grid_group grid = cg::this_grid();
    if (threadIdx.x < 4) ((LAS unsigned*)(lds + LDS_BARST))[threadIdx.x] = 0u;
    __syncthreads();
    XcdBarrier bar; bar.bar = (unsigned*)(p.ws + WS_BAR); bar.x = 0; bar.st = (volatile LAS unsigned*)(lds + LDS_BARST);
    if (p.ph_hi > p.ph_lo) bar = xcd_barrier_post((unsigned*)(p.ws + WS_BAR), (volatile LAS unsigned*)(lds + LDS_BARST));
    unsigned char* ws = p.ws; const int G = gridDim.x, bid = blockIdx.x;
    bf16_t* XB = (bf16_t*)(ws + WS_XB); bf16_t* BIG = (bf16_t*)(ws + WS_BIG); float* Y = p.out; bf16_t* Zb = (bf16_t*)p.out; bf16_t* SLAB = (bf16_t*)(ws + WS_SLAB);
#ifndef REPMASK
#define REPMASK 0
#endif
#define RUN(k) (((PHMASK >> (k)) & 1) && p.ph_lo <= (k) && (k) <= p.ph_hi)
#define DO2(k, ...) do { if ((REPMASK >> (k)) & 1) { __VA_ARGS__ } __VA_ARGS__ } while (0)
#if USE_CG_SYNC
#define SEAM(k) do { if (p.ph_lo <= (k) && (k) < p.ph_hi) grid.sync(); } while (0)
#else
#define SEAM(k) do { if (p.ph_lo <= (k) && (k) < p.ph_hi) xcd_barrier(bar); } while (0)
#endif
    if (RUN(0)) DO2(0, { phase_prep(p, lds); });
    SEAM(0);
    if (RUN(1)) DO2(1, { pg8::Gemm g{XB, (const bf16_t*)(ws + WS_WIN), T, 6144, 1024, 1024}; pg8::StaticOrder S; S.init(T, 6144, G, bid, 1024);
        pg8::EpiG1 E{Zb, BIG};
        pg8::gemm_phase<pg8::EpiG1, pg8::StaticOrder, true, true>(lds, g, S, E);
        phase_dt(p); });
    SEAM(1);
#ifdef PROBE_SCAN2
    if (RUN(2)) phase_scan<true>(p, lds);
#endif
    if (RUN(2)) phase_scan<false>(p, lds);
    SEAM(2);
    if (RUN(3)) phase_gnorm(p);
    SEAM(3);
    if (RUN(4)) DO2(4, { pg8::Gemm g{Zb, (const bf16_t*)(ws + WS_WOUT), T, 1024, 2048, 2048}; pg8::SplitOrder S; S.init(G, bid, 2048);
        pg8::EpiRes E{p.in[0], p.in[1], (float*)(ws + WS_BIG), DN_ALPHA, SLAB};
        pg8::gemm_phase<pg8::EpiRes, pg8::SplitOrder, true, true>(lds, g, S, E); });
    SEAM(4);
    if (RUN(5)) DO2(5, { phase_ln((const float*)(ws + WS_BIG), p.in[1], SLAB, Y, XB, p.in[21], p.in[22]); });
    SEAM(5);
    if (RUN(6)) DO2(6, { pg8::Gemm g{XB, (const bf16_t*)(ws + WS_W1), T, 4096, 1024, 1024}; pg8::StaticOrder S; S.init(T, 4096, G, bid, 1024);
        pg8::EpiAct<1> E{BIG, 4096, nullptr};
        pg8::gemm_phase<pg8::EpiAct<1>, pg8::StaticOrder, true, true>(lds, g, S, E); });
    SEAM(6);
    if (RUN(7)) { pg8::Gemm g{BIG, (const bf16_t*)(ws + WS_W2), T, 1024, 4096, 4096}; pg8::SplitOrder S; S.init(G, bid, 4096);
        pg8::EpiRes E{Y, Y + (size_t)TP * 1024, Y, DN_ALPHA, SLAB};
        pg8::gemm_phase<pg8::EpiRes, pg8::SplitOrder, true, true>(lds, g, S, E); }
    SEAM(7);
    if (RUN(8)) phase_ln(Y, Y + (size_t)TP * 1024, SLAB, Y, XB, p.in[23], p.in[24]);
    SEAM(8);
    if (RUN(9)) DO2(9, { pg8::Gemm g{XB, (const bf16_t*)(ws + WS_CMWIN), T, 4096, 1024, 1024}; pg8::StaticOrder S; S.init(T, 4096, G, bid, 1024);
        pg8::EpiAct<2> E{BIG, 4096, p.in[13]};
        pg8::gemm_phase<pg8::EpiAct<2>, pg8::StaticOrder, true, true>(lds, g, S, E); });
    SEAM(9);
    if (RUN(10)) phase_lnv(p);
    SEAM(10);
#ifdef PROBE_SPATIAL2
    if (RUN(11)) phase_spatial<true>(p, lds);
#endif
    if (RUN(11)) phase_spatial<false>(p, lds);
#ifdef PROBE_SYNC
    for (int i_ = 0; i_ < 16; ++i_) grid.sync();
#endif
    SEAM(11);
    if (RUN(12)) { pg8::Gemm g{BIG, (const bf16_t*)(ws + WS_CMWOUT), T, 1024, 2048, 4096}; pg8::SplitOrder S; S.init(G, bid, 2048);
        pg8::EpiRes E{Y, Y + (size_t)TP * 1024, Y, DN_ALPHA, SLAB};
        pg8::gemm_phase<pg8::EpiRes, pg8::SplitOrder, true, true>(lds, g, S, E); }
    SEAM(12);
    if (RUN(13)) phase_ln(Y, Y + (size_t)TP * 1024, SLAB, Y, XB, p.in[21] + 1024, p.in[22] + 1024);
    SEAM(13);
    if (RUN(14)) DO2(14, { pg8::Gemm g{XB, (const bf16_t*)(ws + WS_W1) + (size_t)4096 * 1024, T, 4096, 1024, 1024}; pg8::StaticOrder S; S.init(T, 4096, G, bid, 1024);
        pg8::EpiAct<1> E{BIG, 4096, nullptr};
        pg8::gemm_phase<pg8::EpiAct<1>, pg8::StaticOrder, true, true>(lds, g, S, E); });
    SEAM(14);
    if (RUN(15)) { pg8::Gemm g{BIG, (const bf16_t*)(ws + WS_W2) + (size_t)4096 * 1024, T, 1024, 4096, 4096}; pg8::SplitOrder S; S.init(G, bid, 4096);
        pg8::EpiRes E{Y, Y + (size_t)TP * 1024, Y, DN_ALPHA, SLAB};
        pg8::gemm_phase<pg8::EpiRes, pg8::SplitOrder, true, true>(lds, g, S, E); }
    SEAM(15);
    if (RUN(16)) phase_ln(Y, Y + (size_t)TP * 1024, SLAB, Y, nullptr, p.in[23] + 1024, p.in[24] + 1024);
    if (p.ph_lo > 1000) grid.sync();
}

#ifndef ONE_LAUNCH
#define ONE_LAUNCH 0
#endif
extern "C" void kernel_launch(void* const* d_in, const int* in_sizes, int n_in, void* d_out, int out_size, void* d_ws, size_t ws_size, hipStream_t stream) {
    static int grid = 0;
    if (grid == 0) {
        if (n_in != 25 || ws_size < WS_NEED) { fprintf(stderr, "kernel_launch: unexpected n_in %d / ws_size %zu\n", n_in, ws_size); grid = -1; return; }
        int dev = 0, cus = 0, per_cu = 0;
        hipGetDevice(&dev); hipDeviceGetAttribute(&cus, hipDeviceAttributeMultiprocessorCount, dev);
        if (hipFuncSetAttribute((const void*)fwd_kernel, hipFuncAttributeMaxDynamicSharedMemorySize, LDS_BYTES) != hipSuccess) { fprintf(stderr, "kernel_launch: hipFuncSetAttribute failed\n"); grid = -1; return; }
        hipOccupancyMaxActiveBlocksPerMultiprocessor(&per_cu, (const void*)fwd_kernel, 512, LDS_BYTES);
        if (per_cu < 1) { fprintf(stderr, "kernel_launch: occupancy query says %d blocks per CU\n", per_cu); per_cu = 1; }
        (void)hipGetLastError();
        grid = cus;
        if (grid != 256) { fprintf(stderr, "kernel_launch: built for a 256-CU device (got %d)\n", cus); grid = -1; return; }
    }
    if (grid < 0) return;
    if (hipMemsetAsync((char*)d_ws + WS_BAR, 0, 16384, stream) != hipSuccess) { fprintf(stderr, "kernel_launch: memset failed\n"); return; }
    Params p{};
    for (int i = 0; i < 25; ++i) p.in[i] = (const float*)d_in[i];
    p.out = (float*)d_out; p.ws = (unsigned char*)d_ws;
#if ONE_LAUNCH
    p.ph_lo = 0; p.ph_hi = NPHASE - 1;
    void* args[] = {&p};
    hipError_t e = hipLaunchCooperativeKernel((const void*)fwd_kernel, dim3(grid), dim3(512), args, LDS_BYTES, stream);
    if (e != hipSuccess) fprintf(stderr, "cooperative launch failed: %s (grid %d)\n", hipGetErrorString(e), grid);
#else
    for (int ph = 0; ph < NPHASE; ++ph) { p.ph_lo = ph; p.ph_hi = ph; hipLaunchKernelGGL(fwd_kernel, dim3(grid), dim3(512), LDS_BYTES, stream, p); }
#endif
}
```

```cpp
#include <hip/hip_runtime.h>
#include <hip/hip_cooperative_groups.h>
#include <cstdio>
#include <cstdint>
namespace cg = cooperative_groups;
#ifndef PHMASK
#define PHMASK 0x1ffff
#endif
#ifndef USE_CG_SYNC
#define USE_CG_SYNC 0
#endif
#ifndef PROBE_NOCONV
#define PROBE_NOCONV 0
#endif
#ifndef ONE_LAUNCH
#define ONE_LAUNCH 1
#endif
namespace pg8 {
#define PG8_LAS __attribute__((address_space(3)))
typedef unsigned short bf16_t;
typedef short bf16x8 __attribute__((ext_vector_type(8)));
typedef float f32x4 __attribute__((ext_vector_type(4)));
typedef unsigned u32x4 __attribute__((ext_vector_type(4)));
constexpr int BM = 256, BK = 64, HALF = 128, HTB = HALF * BK * 2  , STAGE_BYTES = 8 * HTB, NXCD = 8, WGM = 8;

__host__ __device__ __forceinline__ int lds_byte(int r, int c) { const int st = (r >> 4) * 2 + (c >> 5), rr = r & 15, cc = c & 31, ob = rr * 64 + cc * 2; return st * 1024 + (ob ^ (((ob >> 9) & 1) << 5)); }
__host__ __device__ __forceinline__ void stage_rc(int b, int& R, int& C) { const int st = b / 1024, sb = b % 1024, swz = sb ^ (((sb >> 9) & 1) << 5); R = (st >> 1) * 16 + swz / 64; C = (st & 1) * 32 + (swz % 64) / 2; }
__host__ __device__ __forceinline__ int perm32(int rho) { const int n = rho >> 4, i = rho & 15; return 8 * (i >> 2) + 4 * n + (i & 3); }

struct Unit { int pm, pn, kofs, nt, slab; };
struct Gemm { const bf16_t* A; const bf16_t* Bt; int M, N, K, lda; };

struct StaticOrder {
    int nM, nN, nwg, G, c, nt;
    __host__ __device__ void init(int M, int N, int G_, int c_, int K_) { nM = M / BM; nN = N / BM; nwg = nM * nN; G = G_; c = c_; nt = K_ / BK; }
    __host__ __device__ bool next(int i, Unit& u) const {
        const long L = (long)i * G + c; if (L >= nwg) return false;
        int wgid = (int)L; { const int q = nwg / NXCD, r = nwg % NXCD, xcd = wgid % NXCD, off = wgid / NXCD; wgid = (xcd < r ? xcd * (q + 1) : r * (q + 1) + (xcd - r) * q) + off; }
        const int nig = WGM * nN, gid = wgid / nig, fm = gid * WGM, gsz = (nM - fm) < WGM ? (nM - fm) : WGM;
        u.pm = fm + ((wgid % nig) % gsz); u.pn = (wgid % nig) / gsz; u.kofs = 0; u.nt = nt; u.slab = -1; return true;
    }
    __device__ __forceinline__ void a_ready(const Unit&) const {}
    __device__ __forceinline__ void done(const Unit&) const {}
};
__device__ __forceinline__ unsigned cvt_pk_bf16(float lo, float hi) { unsigned r; asm volatile("v_cvt_pk_bf16_f32 %0, %1, %2" : "=v"(r) : "v"(lo), "v"(hi)); return r; }

constexpr int TP_ROWS = 16384;
typedef unsigned u32x2 __attribute__((ext_vector_type(2)));
struct EpiG1 {
    static constexpr bool PERM = true, AFTER_DRAIN = false;
    bf16_t* Z; bf16_t* XBC;
    __device__ __forceinline__ void operator()(const f32x4 (&acc)[2][2][4][2], const Unit& u, int wr, int wc, int fr, int fq) const {
        const int row0 = u.pm * BM + wr * 64 + fr; const int colt = u.pn * BM;
        const bool isx = colt >= 2048;
        bf16_t* base = isx ? XBC : Z; const int ldc = isx ? 4096 : 2048; const int col0 = (isx ? colt - 2048 : colt) + wc * 32 + 8 * fq;
#pragma unroll
        for (int ai = 0; ai < 2; ++ai)
#pragma unroll
            for (int m = 0; m < 4; ++m) { bf16_t* rowp = base + (size_t)(row0 + ai * HALF + m * 16) * ldc + col0;
#pragma unroll
                for (int bj = 0; bj < 2; ++bj) { const f32x4 v0 = acc[ai][bj][m][0], v1 = acc[ai][bj][m][1];
                    u32x4 w; w.x = cvt_pk_bf16(v0[0], v0[1]); w.y = cvt_pk_bf16(v0[2], v0[3]); w.z = cvt_pk_bf16(v1[0], v1[1]); w.w = cvt_pk_bf16(v1[2], v1[3]);
                    *(u32x4*)(rowp + bj * HALF) = w; } }
    }
};
__device__ __forceinline__ float act_relu2(float v) { const float r = v > 0.f ? v : 0.f; return r * r; }
__device__ __forceinline__ float act_gelu_tanh(float v) { const float u = 0.7978845608f * (v + 0.044715f * v * v * v); return v * __builtin_amdgcn_rcpf(1.0f + __expf(-2.0f * u)); }
template <int ACT> struct EpiAct {
    static constexpr bool PERM = true, AFTER_DRAIN = false;
    bf16_t* O; int ldc; const float* bias;
    __device__ __forceinline__ void operator()(const f32x4 (&acc)[2][2][4][2], const Unit& u, int wr, int wc, int fr, int fq) const {
        const int row0 = u.pm * BM + wr * 64 + fr; const int col0 = u.pn * BM + wc * 32 + 8 * fq;
        f32x4 bv[2][2];
#pragma unroll
        for (int bj = 0; bj < 2; ++bj)
#pragma unroll
            for (int n = 0; n < 2; ++n) bv[bj][n] = (ACT == 2) ? *(const f32x4*)(bias + col0 + bj * HALF + 4 * n) : (f32x4){0.f, 0.f, 0.f, 0.f};
#pragma unroll
        for (int ai = 0; ai < 2; ++ai)
#pragma unroll
            for (int m = 0; m < 4; ++m) { bf16_t* rowp = O + (size_t)(row0 + ai * HALF + m * 16) * ldc + col0;
#pragma unroll
                for (int bj = 0; bj < 2; ++bj) { f32x4 v0 = acc[ai][bj][m][0] + bv[bj][0], v1 = acc[ai][bj][m][1] + bv[bj][1];
#pragma unroll
                    for (int j = 0; j < 4; ++j) { if (ACT == 1) { v0[j] = act_relu2(v0[j]); v1[j] = act_relu2(v1[j]); } else { v0[j] = act_gelu_tanh(v0[j]); v1[j] = act_gelu_tanh(v1[j]); } }
                    u32x4 w; w.x = cvt_pk_bf16(v0[0], v0[1]); w.y = cvt_pk_bf16(v0[2], v0[3]); w.z = cvt_pk_bf16(v1[0], v1[1]); w.w = cvt_pk_bf16(v1[2], v1[3]);
                    *(u32x4*)(rowp + bj * HALF) = w; } }
    }
};
struct EpiRes {
    static constexpr bool PERM = false, AFTER_DRAIN = false;
    const float* resP; const float* resS; float* out; float alpha; bf16_t* slabs;
    __device__ __forceinline__ void operator()(const f32x4 (&acc)[2][2][4][2], const Unit& u, int wr, int wc, int fr, int fq) const {
        if (u.slab >= 0) { bf16_t* sp = slabs + (size_t)u.slab * 65536 + (wr * 64 + fr) * 256 + wc * 32 + 4 * fq;
#pragma unroll
            for (int ai = 0; ai < 2; ++ai)
#pragma unroll
                for (int m = 0; m < 4; ++m)
#pragma unroll
                    for (int bj = 0; bj < 2; ++bj)
#pragma unroll
                        for (int n = 0; n < 2; ++n) { const f32x4 v = acc[ai][bj][m][n]; u32x2 w; w.x = cvt_pk_bf16(v[0], v[1]); w.y = cvt_pk_bf16(v[2], v[3]); *(u32x2*)(sp + (ai * HALF + m * 16) * 256 + bj * HALF + n * 16) = w; }
            return; }
        const int row0 = u.pm * BM + wr * 64 + fr, col0 = u.pn * BM + wc * 32 + 4 * fq;
#pragma unroll
        for (int ai = 0; ai < 2; ++ai)
#pragma unroll
            for (int m = 0; m < 4; ++m) { const int row = row0 + ai * HALF + m * 16;
                const float* rp = (row < TP_ROWS ? resP + (size_t)row * 1024 : resS + (size_t)(row - TP_ROWS) * 1024) + col0; float* op = out + (size_t)row * 1024 + col0;
#pragma unroll
                for (int bj = 0; bj < 2; ++bj)
#pragma unroll
                    for (int n = 0; n < 2; ++n) { const f32x4 r = *(const f32x4*)(rp + bj * HALF + n * 16); *(f32x4*)(op + bj * HALF + n * 16) = r * alpha + acc[ai][bj][m][n]; } }
    }
};
struct SplitOrder {
    StaticOrder so; int K, c;
    __device__ void init(int G_, int c_, int K_) { so.init(TP_ROWS, 1024, G_, c_, K_); K = K_; c = c_; }
    __device__ bool next(int i, Unit& u) const {
        if (i == 0) return so.next(0, u);
        if (i == 1 && c < 128) { u.pm = 64 + (c >> 4); u.pn = (c >> 2) & 3; u.kofs = (c & 3) * (K >> 2); u.nt = K >> 8; u.slab = c; return true; }
        return false; }
    __device__ __forceinline__ void a_ready(const Unit&) const {}
    __device__ __forceinline__ void done(const Unit&) const {}
};
template <class Epi, class Sched, bool ALIGN_EPI = false, bool SP2 = false>
__device__ __forceinline__ void gemm_phase(PG8_LAS unsigned char* lds, const Gemm g, const Sched& S, const Epi& E) {
    const int tid = threadIdx.x, wid = __builtin_amdgcn_readfirstlane(tid >> 6), lane = tid & 63, wr = wid >> 2, wc = wid & 3, fr = lane & 15, fq = lane >> 4;
    const int K = g.K;
    unsigned voffA[2], voffB[2];
#pragma unroll
    for (int i = 0; i < 2; ++i) { int R, C; stage_rc(tid * 16 + i * 8192, R, C); const int Rb = Epi::PERM ? ((R & ~31) + perm32(R & 31)) : R;
        voffA[i] = (unsigned)(R * g.lda + C) * 2u; voffB[i] = (unsigned)(Rb * K + C) * 2u; }
    const size_t kstep = (size_t)(BK * 2);
    const size_t hstepA = (size_t)HALF * g.lda * 2, hstepB = (size_t)HALF * K * 2;
    const size_t tstepA = 2 * hstepA, tstepB = 2 * hstepB;
    const unsigned ldsw = (unsigned)wid * 1024u;
    const int aoff = lds_byte(wr * 64 + fr, fq * 8), boff = lds_byte(wc * 32 + fr, fq * 8);
#define PG8_SA(b, h) (((b) * 2 + (h)) * HTB)
#define PG8_SB(b, h) ((4 + (b) * 2 + (h)) * HTB)
#define PG8_STAGE(bufoff, gbase, voff) do { _Pragma("unroll") for (int _i = 0; _i < 2; ++_i) \
        __builtin_amdgcn_global_load_lds((const unsigned*)((const char*)(gbase) + (voff)[_i]), (PG8_LAS unsigned*)(lds + (bufoff) + ldsw + _i * 8192), 16, 0, 0); } while (0)
#define PG8_LDA(dst, b, h) do { _Pragma("unroll") for (int m = 0; m < 4; ++m) _Pragma("unroll") for (int k = 0; k < 2; ++k) dst[m][k] = *(const PG8_LAS bf16x8*)(lds + PG8_SA(b, h) + aoff + m * 2048 + k * 1024); } while (0)
#define PG8_LDB(dst, b, h) do { _Pragma("unroll") for (int n = 0; n < 2; ++n) _Pragma("unroll") for (int k = 0; k < 2; ++k) dst[n][k] = *(const PG8_LAS bf16x8*)(lds + PG8_SB(b, h) + boff + n * 2048 + k * 1024); } while (0)
#define PG8_MMA(ai, bj, At, Bt) do { __builtin_amdgcn_s_setprio(1); _Pragma("unroll") for (int m = 0; m < 4; ++m) _Pragma("unroll") for (int n = 0; n < 2; ++n) _Pragma("unroll") for (int k = 0; k < 2; ++k) \
        acc[ai][bj][m][n] = __builtin_amdgcn_mfma_f32_16x16x32_bf16(Bt[n][k], At[m][k], acc[ai][bj][m][n], 0, 0, 0); __builtin_amdgcn_s_setprio(0); } while (0)
#define PG8_WAIT_V(n) asm volatile("s_waitcnt vmcnt(" #n ")" ::: "memory")
#define PG8_WAIT_L(n) asm volatile("s_waitcnt lgkmcnt(" #n ")" ::: "memory")
#define PG8_BAR __builtin_amdgcn_s_barrier()
#define PG8_SCHED __builtin_amdgcn_sched_barrier(0)
    Unit cur, nxt; int ui = 0;
    if (!S.next(0, cur)) return;
    f32x4 acc[2][2][4][2];
#pragma unroll
    for (int a = 0; a < 2; ++a)
#pragma unroll
        for (int b = 0; b < 2; ++b)
#pragma unroll
            for (int m = 0; m < 4; ++m)
#pragma unroll
                for (int n = 0; n < 2; ++n) acc[a][b][m][n] = (f32x4){0.f, 0.f, 0.f, 0.f};
    bf16x8 At[4][2], B0[2][2], B1[2][2];
    const char* cA = (const char*)g.A + (size_t)cur.pm * tstepA + (size_t)cur.kofs * 2; const char* cB = (const char*)g.Bt + (size_t)cur.pn * tstepB + (size_t)cur.kofs * 2;
    S.a_ready(cur);
    if constexpr (SP2) {
        PG8_STAGE(PG8_SB(0, 0), cB, voffB); PG8_STAGE(PG8_SB(0, 1), cB + hstepB, voffB); PG8_STAGE(PG8_SA(0, 0), cA, voffA); PG8_STAGE(PG8_SA(0, 1), cA + hstepA, voffA);
        if (wr == 1) PG8_BAR;
        PG8_WAIT_V(2); PG8_BAR;
        PG8_STAGE(PG8_SB(1, 0), cB + kstep, voffB); PG8_STAGE(PG8_SA(1, 0), cA + kstep, voffA); PG8_STAGE(PG8_SB(1, 1), cB + hstepB + kstep, voffB);
        PG8_WAIT_V(6); PG8_BAR;
    } else {
        PG8_STAGE(PG8_SB(0, 0), cB, voffB); PG8_STAGE(PG8_SA(0, 0), cA, voffA); PG8_STAGE(PG8_SB(0, 1), cB + hstepB, voffB); PG8_STAGE(PG8_SA(0, 1), cA + hstepA, voffA);
        if (wr == 1) PG8_BAR;
        PG8_WAIT_V(4); PG8_BAR;
        PG8_STAGE(PG8_SB(1, 0), cB + kstep, voffB); PG8_STAGE(PG8_SA(1, 0), cA + kstep, voffA); PG8_STAGE(PG8_SB(1, 1), cB + hstepB + kstep, voffB);
        PG8_WAIT_V(6); PG8_BAR;
    }
    for (;;) {
        const bool has_next = S.next(ui + 1, nxt);
        const char* nA = has_next ? (const char*)g.A + (size_t)nxt.pm * tstepA + (size_t)nxt.kofs * 2 : cA; const char* nB = has_next ? (const char*)g.Bt + (size_t)nxt.pn * tstepB + (size_t)nxt.kofs * 2 : cB;
        const int nt = cur.nt;
        for (int t = 0; t < nt; t += 2) {
            const bool last = (t == nt - 2);
            const char* a1 = cA + (size_t)(t + 1) * kstep;
            const char* a2 = last ? nA : cA + (size_t)(t + 2) * kstep; const char* b2 = last ? nB : cB + (size_t)(t + 2) * kstep;
            const char* a3 = a2 + kstep; const char* b3 = b2 + kstep;
            if (last && has_next) S.a_ready(nxt);
            if constexpr (SP2) {
            PG8_LDB(B0, 0, 0); PG8_LDB(B1, 0, 1); PG8_SCHED; PG8_LDA(At, 0, 0); PG8_STAGE(PG8_SA(1, 1), a1 + hstepA, voffA);
            PG8_WAIT_V(8); PG8_WAIT_L(0); PG8_BAR; PG8_MMA(0, 0, At, B0); PG8_MMA(0, 1, At, B1); PG8_BAR; PG8_SCHED;
            PG8_LDA(At, 0, 1); PG8_STAGE(PG8_SB(0, 0), b2, voffB); PG8_STAGE(PG8_SB(0, 1), b2 + hstepB, voffB); PG8_STAGE(PG8_SA(0, 0), a2, voffA);
            PG8_WAIT_V(8); PG8_WAIT_L(0); PG8_BAR; PG8_MMA(1, 0, At, B0); PG8_MMA(1, 1, At, B1); PG8_BAR; PG8_SCHED;
            PG8_LDB(B0, 1, 0); PG8_LDB(B1, 1, 1); PG8_SCHED; PG8_LDA(At, 1, 0); PG8_STAGE(PG8_SA(0, 1), a2 + hstepA, voffA);
            PG8_WAIT_V(8); PG8_WAIT_L(0); PG8_BAR; PG8_MMA(0, 0, At, B0); PG8_MMA(0, 1, At, B1); PG8_BAR; PG8_SCHED;
            PG8_LDA(At, 1, 1); PG8_STAGE(PG8_SB(1, 0), b3, voffB); PG8_STAGE(PG8_SB(1, 1), b3 + hstepB, voffB); PG8_STAGE(PG8_SA(1, 0), a3, voffA);
            PG8_WAIT_V(8); PG8_WAIT_L(0); PG8_BAR; PG8_MMA(1, 0, At, B0); PG8_MMA(1, 1, At, B1); PG8_BAR; PG8_SCHED;
            } else {
            PG8_LDB(B0, 0, 0); PG8_SCHED; PG8_LDA(At, 0, 0); PG8_STAGE(PG8_SA(1, 1), a1 + hstepA, voffA);
            PG8_WAIT_L(8); PG8_BAR; PG8_WAIT_L(0); PG8_MMA(0, 0, At, B0); PG8_BAR; PG8_SCHED;
            PG8_LDB(B1, 0, 1); PG8_STAGE(PG8_SB(0, 0), b2, voffB);
            PG8_BAR; PG8_WAIT_L(0); PG8_MMA(0, 1, At, B1); PG8_BAR;
            PG8_LDA(At, 0, 1); PG8_STAGE(PG8_SA(0, 0), a2, voffA);
            PG8_BAR; PG8_WAIT_L(0); PG8_MMA(1, 0, At, B0); PG8_BAR; PG8_SCHED;
            PG8_STAGE(PG8_SB(0, 1), b2 + hstepB, voffB);
            PG8_WAIT_V(6); PG8_BAR; PG8_MMA(1, 1, At, B1); PG8_BAR;
            PG8_LDB(B0, 1, 0); PG8_SCHED; PG8_LDA(At, 1, 0); PG8_STAGE(PG8_SA(0, 1), a2 + hstepA, voffA);
            PG8_WAIT_L(8); PG8_BAR; PG8_WAIT_L(0); PG8_MMA(0, 0, At, B0); PG8_BAR; PG8_SCHED;
            PG8_LDB(B1, 1, 1); PG8_STAGE(PG8_SB(1, 0), b3, voffB);
            PG8_BAR; PG8_WAIT_L(0); PG8_MMA(0, 1, At, B1); PG8_BAR;
            PG8_LDA(At, 1, 1); PG8_STAGE(PG8_SA(1, 0), a3, voffA);
            PG8_BAR; PG8_WAIT_L(0); PG8_MMA(1, 0, At, B0); PG8_BAR; PG8_SCHED;
            PG8_STAGE(PG8_SB(1, 1), b3 + hstepB, voffB);
            PG8_WAIT_V(6); PG8_BAR; PG8_MMA(1, 1, At, B1); PG8_BAR;
            }
        }
        if constexpr (ALIGN_EPI) { if (wr == 0) PG8_BAR; }
        if constexpr (!Epi::AFTER_DRAIN) { E(acc, cur, wr, wc, fr, fq); S.done(cur); }
        if (!has_next) break;
#pragma unroll
        for (int a = 0; a < 2; ++a)
#pragma unroll
            for (int b = 0; b < 2; ++b)
#pragma unroll
                for (int m = 0; m < 4; ++m)
#pragma unroll
                    for (int n = 0; n < 2; ++n) acc[a][b][m][n] = (f32x4){0.f, 0.f, 0.f, 0.f};
        cur = nxt; cA = nA; cB = nB; ++ui;
        if constexpr (ALIGN_EPI) { if (wr == 1) PG8_BAR; }
    }
    PG8_WAIT_V(0);
    if constexpr (!ALIGN_EPI) { if (wr == 0) PG8_BAR; }
    PG8_BAR;
    if constexpr (Epi::AFTER_DRAIN) { E.fused(acc, cur, wr, wc, fr, fq, lds, wid, lane); S.done(cur); }
#undef PG8_SA
#undef PG8_SB
#undef PG8_STAGE
#undef PG8_LDA
#undef PG8_LDB
#undef PG8_MMA
#undef PG8_WAIT_V
#undef PG8_WAIT_L
#undef PG8_BAR
#undef PG8_SCHED
}
}

#define LAS __attribute__((address_space(3)))
typedef LAS unsigned char* ldsp;
using pg8::bf16_t; using pg8::bf16x8; using pg8::f32x4; using pg8::u32x4; using pg8::cvt_pk_bf16;
using pg8::u32x2;

#define XB_TMO      128
#define XB_XCNT(j)  (256  + 64 * (j))
#define XB_XSUB(j)  (1280 + 64 * (j))
#define XB_XGEN(j)  (2304 + 64 * (j))
#define XB_TOP      3328
#define XB_TOPGEN   3392
#define XCD_BAR_WORDS 3456
#define XB_SPIN_CAP (1u << 18)

__device__ __forceinline__ unsigned xb_ld(unsigned* p)              { return __hip_atomic_load(p, __ATOMIC_RELAXED, __HIP_MEMORY_SCOPE_AGENT); }
__device__ __forceinline__ unsigned xb_add(unsigned* p, unsigned v) { return __hip_atomic_fetch_add(p, v, __ATOMIC_RELAXED, __HIP_MEMORY_SCOPE_AGENT); }
__device__ __forceinline__ unsigned xb_xcc_id() { return (unsigned)__builtin_amdgcn_s_getreg((3 << 11) | 20) & 0xFu; }
#define XB_SPIN(cond, bar) do { unsigned _sp = 0; while (cond) { __builtin_amdgcn_s_sleep(1); \
    if ((++_sp & 255u) == 0u) { if (xb_ld(&(bar)[XB_TMO])) break; if (_sp > XB_SPIN_CAP) { atomicAdd(&(bar)[XB_TMO], 1u); break; } } } } while (0)

struct XcdBarrier {
    unsigned* bar; unsigned x;
    volatile LAS unsigned* st;
};

__device__ __forceinline__ XcdBarrier xcd_barrier_post(unsigned* bar, volatile LAS unsigned* st) {
    XcdBarrier b; b.bar = bar; b.x = xb_xcc_id(); b.st = st;
    if (threadIdx.x == 0) (void)xb_add(&bar[XB_XCNT(b.x)], 1u);
    return b;
}
__device__ __forceinline__ void xcd_barrier_complete(unsigned* bar, unsigned x, unsigned& nloc, unsigned& nx) {
    const unsigned G = gridDim.x * gridDim.y * gridDim.z;
    unsigned sum, cnt, mine, sp = 0u;
    for (;;) {
        sum = 0u; cnt = 0u; mine = 0u;
#pragma unroll
        for (unsigned j = 0; j < 16; ++j) { const unsigned c = xb_ld(&bar[XB_XCNT(j)]); sum += c; cnt += (c > 0u) ? 1u : 0u; mine = (j == x) ? c : mine; }
        if (sum == G) break;
        __builtin_amdgcn_s_sleep(1);
        if ((++sp & 255u) == 0u) { if (xb_ld(&bar[XB_TMO])) break; if (sp > XB_SPIN_CAP) { atomicAdd(&bar[XB_TMO], 1u); break; } }
    }
    nloc = mine > 0u ? mine : 1u; nx = cnt > 0u ? cnt : 1u;
}

__device__ __forceinline__ void xcd_barrier(const XcdBarrier& b) {
    asm volatile("s_waitcnt vmcnt(0)" ::: "memory");
    __syncthreads();
    if (threadIdx.x == 0) {
        unsigned* bar = b.bar;
        __builtin_amdgcn_s_waitcnt(0);
        unsigned nloc = b.st[0], nx = b.st[1];
        if (nloc == 0u) { xcd_barrier_complete(bar, b.x, nloc, nx); b.st[0] = nloc; b.st[1] = nx; }
        const unsigned old = xb_add(&bar[XB_XSUB(b.x)], 1u);
        const unsigned gen = old / nloc;
        if (old + 1u == (gen + 1u) * nloc) {
            __builtin_amdgcn_fence(__ATOMIC_RELEASE, "agent");
            asm volatile("s_waitcnt vmcnt(0)" ::: "memory");
            const unsigned og = xb_add(&bar[XB_TOP], 1u);
            const unsigned tg = og / nx;
            if (og + 1u == (tg + 1u) * nx) xb_add(&bar[XB_TOPGEN], 1u);
            else XB_SPIN(xb_ld(&bar[XB_TOPGEN]) == tg, bar);
            __builtin_amdgcn_fence(__ATOMIC_ACQUIRE, "agent");
            xb_add(&bar[XB_XGEN(b.x)], 1u);
            asm volatile("s_waitcnt vmcnt(0)" ::: "memory");
        } else {
            XB_SPIN(xb_ld(&bar[XB_XGEN(b.x)]) == gen, bar);
            __builtin_amdgcn_fence(__ATOMIC_ACQUIRE, "agent");
            asm volatile("s_waitcnt vmcnt(0)" ::: "memory");
        }
    }
    __syncthreads();
}

constexpr int T = 18432, TP = 16384, DM = 1024;
constexpr float DN_ALPHA = 1.41421356237f;
constexpr float LN_EPS = 1e-5f;
constexpr size_t O_YP = 0, O_YS = 16777216, O_SSMP = 18874368, O_CONVP = 20971520, O_SSMS = 21069824, O_CONVS = 29458432, O_VROWS = 29851648;
constexpr size_t WS_XB = 0, WS_BIG = 37748736, WS_WOUT = 188743680, WS_W1 = 192937984, WS_W2 = 209715200, WS_CMWIN = 226492416, WS_CMWOUT = 234881024, WS_BAR = 239075328, WS_WIN = 239091712, WS_DT = 251740160, WS_END = 254099456, WS_BND = 256000000;
constexpr size_t WS_SLAB = WS_WIN, WS_NEED = WS_BND + 7077888;
constexpr int LDS_BYTES = 149504, LDS_BARST = 149472;
constexpr int NPHASE = 17;

struct Params { const float* in[25]; float* out; unsigned char* ws; int ph_lo, ph_hi; };

__device__ __forceinline__ float bf_lo(unsigned w) { return __uint_as_float(w << 16); }
__device__ __forceinline__ float bf_hi(unsigned w) { return __uint_as_float(w & 0xffff0000u); }
__device__ __forceinline__ unsigned short f2bf(float f) { unsigned u = __float_as_uint(f); u += 0x7FFFu + ((u >> 16) & 1u); return (unsigned short)(u >> 16); }
__device__ __forceinline__ float silu_f(float x) { return x * __builtin_amdgcn_rcpf(1.0f + __expf(-x)); }
__device__ __forceinline__ float wave_sum(float v) {
#pragma unroll
    for (int o = 32; o >= 1; o >>= 1) v += __shfl_xor(v, o);
    return v;
}
__device__ __forceinline__ f32x4 mfma16(bf16x8 a, bf16x8 b, f32x4 c) { return __builtin_amdgcn_mfma_f32_16x16x32_bf16(a, b, c, 0, 0, 0); }

__device__ __forceinline__ void transpose_cvt(const float* __restrict__ W, int K, int N, bf16_t* __restrict__ WT, ldsp lds) {
    LAS float* tile = (LAS float*)lds;
    const int tid = threadIdx.x; const int ntn = (N + 63) / 64, ntiles = (K / 64) * ntn;
    for (int t = blockIdx.x; t < ntiles; t += gridDim.x) {
        const int k0 = (t / ntn) * 64, n0 = (t % ntn) * 64;
#pragma unroll
        for (int i = 0; i < 8; ++i) { const int k = (tid >> 6) + 8 * i, n = tid & 63; tile[k * 65 + n] = (n0 + n < N) ? W[(size_t)(k0 + k) * N + n0 + n] : 0.f; }
        __syncthreads();
#pragma unroll
        for (int i = 0; i < 4; ++i) { const int kp = 2 * (tid & 31), nn = (tid >> 5) + 16 * i;
            if (n0 + nn < N) *(unsigned*)(WT + (size_t)(n0 + nn) * K + k0 + kp) = cvt_pk_bf16(tile[kp * 65 + nn], tile[(kp + 1) * 65 + nn]); }
        __syncthreads();
    }
}
__device__ __forceinline__ void phase_prep(const Params& p, ldsp lds) {
    unsigned char* ws = p.ws;
    transpose_cvt(p.in[4], 1024, 6176, (bf16_t*)(ws + WS_WIN), lds);
    transpose_cvt(p.in[11], 2048, 1024, (bf16_t*)(ws + WS_WOUT), lds);
    transpose_cvt(p.in[19], 1024, 4096, (bf16_t*)(ws + WS_W1), lds);
    transpose_cvt(p.in[19] + (size_t)1024 * 4096, 1024, 4096, (bf16_t*)(ws + WS_W1) + (size_t)4096 * 1024, lds);
    transpose_cvt(p.in[20], 4096, 1024, (bf16_t*)(ws + WS_W2), lds);
    transpose_cvt(p.in[20] + (size_t)4096 * 1024, 4096, 1024, (bf16_t*)(ws + WS_W2) + (size_t)4096 * 1024, lds);
    transpose_cvt(p.in[12], 1024, 4096, (bf16_t*)(ws + WS_CMWIN), lds);
    transpose_cvt(p.in[18], 2048, 1024, (bf16_t*)(ws + WS_CMWOUT), lds);
    const f32x4* xp = (const f32x4*)p.in[0]; const f32x4* xs = (const f32x4*)p.in[1]; u32x2* xb = (u32x2*)(ws + WS_XB);
    const int n4p = TP * DM / 4, n4 = T * DM / 4;
    for (int i = blockIdx.x * 512 + threadIdx.x; i < n4; i += gridDim.x * 512) { const f32x4 v = (i < n4p) ? xp[i] : xs[i - n4p]; u32x2 w; w.x = cvt_pk_bf16(v[0], v[1]); w.y = cvt_pk_bf16(v[2], v[3]); xb[i] = w; }
}

__device__ __forceinline__ void phase_dt(const Params& p) {
    const int tid = threadIdx.x, wid = tid >> 6, lane = tid & 63;
    const bf16_t* XB = (const bf16_t*)(p.ws + WS_XB); const bf16_t* WT = (const bf16_t*)(p.ws + WS_WIN) + (size_t)6144 * 1024; float* DT = (float*)(p.ws + WS_DT);
    const float* bias = p.in[7];
    for (int tile = blockIdx.x * 8 + wid; tile < T / 16; tile += gridDim.x * 8) {
        f32x4 a0 = {0.f, 0.f, 0.f, 0.f}, a1 = {0.f, 0.f, 0.f, 0.f};
        const bf16_t* ap = XB + (size_t)(tile * 16 + (lane & 15)) * 1024 + 8 * (lane >> 4);
        const bf16_t* bp0 = WT + (size_t)(lane & 15) * 1024 + 8 * (lane >> 4); const bf16_t* bp1 = bp0 + 16 * 1024;
#pragma unroll 4
        for (int kk = 0; kk < 32; ++kk) { const bf16x8 a = *(const bf16x8*)(ap + kk * 32), b0 = *(const bf16x8*)(bp0 + kk * 32), b1 = *(const bf16x8*)(bp1 + kk * 32); a0 = mfma16(a, b0, a0); a1 = mfma16(a, b1, a1); }
        const int hd = lane & 15; const float bb0 = bias[hd], bb1 = bias[16 + hd];
#pragma unroll
        for (int r = 0; r < 4; ++r) { const int tok = tile * 16 + (lane >> 4) * 4 + r; const float x0 = a0[r] + bb0, x1 = a1[r] + bb1;
            DT[(size_t)tok * 32 + hd] = x0 > 20.f ? x0 : log1pf(__expf(x0)); DT[(size_t)tok * 32 + 16 + hd] = x1 > 20.f ? x1 : log1pf(__expf(x1)); }
    }
}

__device__ __forceinline__ void phase_conv(const Params& p, const XcdBarrier& bar) {
    const int wid = threadIdx.x >> 6, lane = threadIdx.x & 63;
    bf16_t* XBC = (bf16_t*)(p.ws + WS_BIG);
    u32x4 hal[2][3];
#pragma unroll
    for (int uu = 0; uu < 2; ++uu) { const int unit = blockIdx.x * 8 + wid + uu * (int)gridDim.x * 8; const int c = unit >> 3, ch = (unit & 7) * 512 + lane * 8;
#pragma unroll
        for (int k = 0; k < 3; ++k) hal[uu][k] = (unit < 2304 && c < 256 && (c & 31) != 0) ? *(const u32x4*)(XBC + (size_t)(64 * c - 3 + k) * 4096 + ch) : (u32x4){0u, 0u, 0u, 0u}; }
    xcd_barrier(bar);
#pragma unroll
    for (int uu = 0; uu < 2; ++uu) { const int unit = blockIdx.x * 8 + wid + uu * (int)gridDim.x * 8; if (unit >= 2304) break;
        const int c = unit >> 3, ch = (unit & 7) * 512 + lane * 8;
        float cw[4][8], cb[8];
#pragma unroll
        for (int k = 0; k < 4; ++k) { const f32x4 a0 = *(const f32x4*)(p.in[5] + k * 4096 + ch), a1 = *(const f32x4*)(p.in[5] + k * 4096 + ch + 4);
#pragma unroll
            for (int e = 0; e < 4; ++e) { cw[k][e] = a0[e]; cw[k][4 + e] = a1[e]; } }
        { const f32x4 a0 = *(const f32x4*)(p.in[6] + ch), a1 = *(const f32x4*)(p.in[6] + ch + 4);
#pragma unroll
            for (int e = 0; e < 4; ++e) { cb[e] = a0[e]; cb[4 + e] = a1[e]; } }
        float xm[3][8];
        const bool seq_last = c >= 256 || (c & 31) == 31;
        if (c >= 256) { const float* cp = p.in[3] + (size_t)(c - 256) * 3 * 4096 + ch;
#pragma unroll
            for (int k = 0; k < 3; ++k) { const f32x4 a0 = *(const f32x4*)(cp + k * 4096), a1 = *(const f32x4*)(cp + k * 4096 + 4);
#pragma unroll
                for (int e = 0; e < 4; ++e) { xm[k][e] = a0[e]; xm[k][4 + e] = a1[e]; } } }
        else {
#pragma unroll
            for (int k = 0; k < 3; ++k) { const u32x4 r = hal[uu][k];
                xm[k][0] = bf_lo(r.x); xm[k][1] = bf_hi(r.x); xm[k][2] = bf_lo(r.y); xm[k][3] = bf_hi(r.y); xm[k][4] = bf_lo(r.z); xm[k][5] = bf_hi(r.z); xm[k][6] = bf_lo(r.w); xm[k][7] = bf_hi(r.w); } }
        float* cdst = (c >= 256 ? p.out + O_CONVS + (size_t)(c - 256) * 3 * 4096 : p.out + O_CONVP + (size_t)(c >> 5) * 3 * 4096) + ch;
        bf16_t* base = XBC + (size_t)(64 * c) * 4096 + ch;
        for (int t0 = 0; t0 < 64; t0 += 8) {
            u32x4 r[8];
#pragma unroll
            for (int i = 0; i < 8; ++i) r[i] = *(const u32x4*)(base + (size_t)(t0 + i) * 4096);
#pragma unroll
            for (int i = 0; i < 8; ++i) {
                const float x0[8] = {bf_lo(r[i].x), bf_hi(r[i].x), bf_lo(r[i].y), bf_hi(r[i].y), bf_lo(r[i].z), bf_hi(r[i].z), bf_lo(r[i].w), bf_hi(r[i].w)};
                float o[8];
#pragma unroll
                for (int e = 0; e < 8; ++e) o[e] = silu_f(cb[e] + cw[0][e] * xm[0][e] + cw[1][e] * xm[1][e] + cw[2][e] * xm[2][e] + cw[3][e] * x0[e]);
                u32x4 w; w.x = cvt_pk_bf16(o[0], o[1]); w.y = cvt_pk_bf16(o[2], o[3]); w.z = cvt_pk_bf16(o[4], o[5]); w.w = cvt_pk_bf16(o[6], o[7]);
                *(u32x4*)(base + (size_t)(t0 + i) * 4096) = w;
                if (seq_last && t0 == 56 && i >= 5) { float* d = cdst + (i - 5) * 4096; *(f32x4*)d = (f32x4){x0[0], x0[1], x0[2], x0[3]}; *(f32x4*)(d + 4) = (f32x4){x0[4], x0[5], x0[6], x0[7]}; }
#pragma unroll
                for (int e = 0; e < 8; ++e) { xm[0][e] = xm[1][e]; xm[1][e] = xm[2][e]; xm[2][e] = x0[e]; } }
        }
    }
}

constexpr int N_CS = 0, N_BS = 17408, N_BT = 34816, N_XDT = 53248, N_XW = 62464, N_XS = 71680, N_HB = 80896, N_WP = 98304, N_DTS = 116736, N_ACS = 116992, N_CW = 117248;
constexpr int ST128 = 272, ST64 = 144;
__device__ __forceinline__ int scan_chan(int j0, int h, int g) { return j0 < 64 ? h * 64 + j0 : (j0 < 192 ? 2048 + g * 128 + (j0 - 64) : 3072 + g * 128 + (j0 - 192)); }
__device__ __forceinline__ int tsw(int row, int slot) { return row * ST64 + ((slot ^ ((row >> 3) & 7)) << 4); }
__device__ __forceinline__ unsigned pk_lolo(unsigned a, unsigned b) { return (a & 0xffffu) | (b << 16); }
__device__ __forceinline__ unsigned pk_hihi(unsigned a, unsigned b) { return (a >> 16) | (b & 0xffff0000u); }
__device__ __forceinline__ float rdlane(float v, int l) { return __int_as_float(__builtin_amdgcn_readlane(__float_as_int(v), l)); }
template <bool DUMMY> __device__ __forceinline__ void phase_scan(const Params& p, ldsp lds) {
    const int tid = threadIdx.x, wid = __builtin_amdgcn_readfirstlane(tid >> 6), lane0 = tid & 63, lane = lane0, fr = lane & 15, fq = lane >> 4;
    const int ti = wid >> 1, half = wid & 1, hp = ti;
    const bool cl = lane < 40;
    const bf16_t* XBC = (const bf16_t*)(p.ws + WS_BIG); bf16_t* Z = (bf16_t*)p.out; const float* DT = (const float*)(p.ws + WS_DT);
    LAS float* dts = (LAS float*)(lds + N_DTS); LAS float* acs = (LAS float*)(lds + N_ACS);
    ldsp wp = lds + N_WP + wid * 2304;
    for (int chain = blockIdx.x; chain < 1280; chain += gridDim.x) {
        int b, h, nsteps, row0; const float* h0 = nullptr; const float* cprev = nullptr; float* hout; float* cdst;
        if (chain < 256) { b = chain >> 5; h = (chain & 7) * 4 + ((chain >> 3) & 3); nsteps = 32; row0 = b * 2048; hout = p.out + O_SSMP + (size_t)(b * 32 + h) * 8192; cdst = p.out + O_CONVP + (size_t)b * 3 * 4096; }
        else { const int i = chain - 256; b = i >> 5; h = (i & 7) * 4 + ((i >> 3) & 3); nsteps = 1; row0 = TP + b * 64; h0 = p.in[2] + (size_t)(b * 32 + h) * 8192; cprev = p.in[3] + (size_t)b * 3 * 4096; hout = p.out + O_SSMS + (size_t)(b * 32 + h) * 8192; cdst = p.out + O_CONVS + (size_t)b * 3 * 4096; }
        const int g = h >> 2; const float A_h = -__expf(p.in[8][h]), D_h = p.in[9][h];
        const int ch0 = scan_chan(cl ? 8 * lane : 0, h, g);
        f32x4 hacc[4];
#pragma unroll
        for (int q = 0; q < 4; ++q)
#pragma unroll
            for (int r = 0; r < 4; ++r) { const int pp = hp * 16 + 4 * fq + r, n = (4 * half + q) * 16 + fr; const float v = h0 ? h0[pp * 128 + n] : 0.f; hacc[q][r] = v;
                *(LAS unsigned short*)(lds + N_HB + pp * ST128 + n * 2) = f2bf(v); }
        u32x4 raw[11]; u32x4 zr; float dtv;
#define SCAN_PREFETCH(s_) do { const int Rn_ = row0 + 64 * (s_); \
            if (cl) { _Pragma("unroll") for (int i = 0; i < 8; ++i) raw[3 + i] = *(const u32x4*)(XBC + (size_t)(Rn_ + 8 * wid + i) * 4096 + ch0); } \
            zr = *(const u32x4*)(Z + (size_t)(Rn_ + 16 * ti + (lane >> 2)) * 2048 + h * 64 + 32 * half + (lane & 3) * 8); \
            dtv = DT[(size_t)(Rn_ + lane) * 32 + h]; } while (0)
#pragma unroll
        for (int i = 0; i < 11; ++i) raw[i] = (u32x4){0u, 0u, 0u, 0u};
        SCAN_PREFETCH(0);
        for (int step = 0; step < nsteps; ++step) {
            const int R = row0 + step * 64;
            int lane_o = lane0; asm volatile("" : "+v"(lane_o));
            const int lane = lane_o, fr = lane & 15, fq = lane >> 4;
            float ac = dtv * A_h;
#pragma unroll
            for (int d = 1; d < 64; d <<= 1) { const float n = __shfl_up(ac, d); if (lane >= d) ac += n; }
            dts[lane] = dtv; acs[lane] = ac;
            const float a_last = rdlane(ac, 63);
            if (false) {
#pragma unroll
                for (int k = 0; k < 3; ++k) { const u32x4 r = raw[8 + k]; float* d = cdst + k * 4096 + ch0;
                    *(f32x4*)d = (f32x4){bf_lo(r.x), bf_hi(r.x), bf_lo(r.y), bf_hi(r.y)}; *(f32x4*)(d + 4) = (f32x4){bf_lo(r.z), bf_hi(r.z), bf_lo(r.w), bf_hi(r.w)}; } }
            if (cl) {
                float s1[8], s2[8];
#pragma unroll
                for (int j = 0; j < 8; ++j) { const float dtt = rdlane(dtv, 8 * wid + j), act = rdlane(ac, 8 * wid + j); s1[j] = dtt; s2[j] = dtt * __expf(a_last - act); }
                const int rmbase = lane < 8 ? N_XS + lane * 16 : (lane < 24 ? N_BS + (lane - 8) * 16 : N_CS + (lane - 24) * 16); const int rmst = lane < 8 ? ST64 : ST128;
#pragma unroll
                for (int j = 0; j < 8; ++j) *(LAS u32x4*)(lds + rmbase + (8 * wid + j) * rmst) = raw[3 + j];
                if (lane < 8) {
#pragma unroll
                    for (int e = 0; e < 8; ++e) { float vv[8];
#pragma unroll
                        for (int j = 0; j < 8; ++j) { const unsigned w = e < 2 ? raw[3 + j].x : e < 4 ? raw[3 + j].y : e < 6 ? raw[3 + j].z : raw[3 + j].w; vv[j] = (e & 1) ? bf_hi(w) : bf_lo(w); }
                        u32x4 v; v.x = cvt_pk_bf16(vv[0] * s1[0], vv[1] * s1[1]); v.y = cvt_pk_bf16(vv[2] * s1[2], vv[3] * s1[3]); v.z = cvt_pk_bf16(vv[4] * s1[4], vv[5] * s1[5]); v.w = cvt_pk_bf16(vv[6] * s1[6], vv[7] * s1[7]);
                        *(LAS u32x4*)(lds + N_XDT + tsw(8 * lane + e, wid)) = v;
                        v.x = cvt_pk_bf16(vv[0] * s2[0], vv[1] * s2[1]); v.y = cvt_pk_bf16(vv[2] * s2[2], vv[3] * s2[3]); v.z = cvt_pk_bf16(vv[4] * s2[4], vv[5] * s2[5]); v.w = cvt_pk_bf16(vv[6] * s2[6], vv[7] * s2[7]);
                        *(LAS u32x4*)(lds + N_XW + tsw(8 * lane + e, wid)) = v; } }
                else if (lane < 24) {
#pragma unroll
                    for (int e = 0; e < 8; ++e) { u32x4 v;
                        const unsigned w0 = e < 2 ? raw[3].x : e < 4 ? raw[3].y : e < 6 ? raw[3].z : raw[3].w, w1 = e < 2 ? raw[4].x : e < 4 ? raw[4].y : e < 6 ? raw[4].z : raw[4].w;
                        const unsigned w2 = e < 2 ? raw[5].x : e < 4 ? raw[5].y : e < 6 ? raw[5].z : raw[5].w, w3 = e < 2 ? raw[6].x : e < 4 ? raw[6].y : e < 6 ? raw[6].z : raw[6].w;
                        const unsigned w4 = e < 2 ? raw[7].x : e < 4 ? raw[7].y : e < 6 ? raw[7].z : raw[7].w, w5 = e < 2 ? raw[8].x : e < 4 ? raw[8].y : e < 6 ? raw[8].z : raw[8].w;
                        const unsigned w6 = e < 2 ? raw[9].x : e < 4 ? raw[9].y : e < 6 ? raw[9].z : raw[9].w, w7 = e < 2 ? raw[10].x : e < 4 ? raw[10].y : e < 6 ? raw[10].z : raw[10].w;
                        if (e & 1) { v.x = pk_hihi(w0, w1); v.y = pk_hihi(w2, w3); v.z = pk_hihi(w4, w5); v.w = pk_hihi(w6, w7); }
                        else       { v.x = pk_lolo(w0, w1); v.y = pk_lolo(w2, w3); v.z = pk_lolo(w4, w5); v.w = pk_lolo(w6, w7); }
                        *(LAS u32x4*)(lds + N_BT + tsw(8 * (lane - 8) + e, wid)) = v; } }
            }
            const u32x4 zcur = zr;
            asm volatile("" ::: "memory"); __builtin_amdgcn_sched_barrier(0);
            if (step + 1 < nsteps) SCAN_PREFETCH(step + 1);
            asm volatile("" ::: "memory"); __builtin_amdgcn_sched_barrier(0);
            __syncthreads();
            f32x4 yacc[2];
            { bf16x8 af[4];
#pragma unroll
                for (int kk = 0; kk < 4; ++kk) af[kk] = *(const LAS bf16x8*)(lds + N_CS + (ti * 16 + fr) * ST128 + (kk * 32 + 8 * fq) * 2);
                float act[4];
#pragma unroll
                for (int r = 0; r < 4; ++r) act[r] = acs[ti * 16 + 4 * fq + r];
#pragma unroll
                for (int si = 0; si < 4; ++si) {
                    if (si <= ti) { f32x4 cb = {0.f, 0.f, 0.f, 0.f};
#pragma unroll
                        for (int kk = 0; kk < 4; ++kk) cb = mfma16(af[kk], *(const LAS bf16x8*)(lds + N_BS + (si * 16 + fr) * ST128 + (kk * 32 + 8 * fq) * 2), cb);
                        const int s = si * 16 + fr; const float as = acs[s];
#pragma unroll
                        for (int r = 0; r < 4; ++r) { const int t = ti * 16 + 4 * fq + r; const float mv = (s <= t) ? cb[r] * __expf(act[r] - as) : 0.f; *(LAS unsigned short*)(wp + (4 * fq + r) * ST64 + s * 2) = f2bf(mv); } }
                    else if (si == (ti | 1)) {
#pragma unroll
                        for (int r = 0; r < 4; ++r) *(LAS unsigned short*)(wp + (4 * fq + r) * ST64 + (si * 16 + fr) * 2) = (unsigned short)0; } }
#pragma unroll
                for (int q = 0; q < 2; ++q) { const int pi = 2 * half + q; f32x4 y = {0.f, 0.f, 0.f, 0.f};
#pragma unroll
                    for (int kk = 0; kk < 4; ++kk) y = mfma16(af[kk], *(const LAS bf16x8*)(lds + N_HB + (pi * 16 + fr) * ST128 + (kk * 32 + 8 * fq) * 2), y);
#pragma unroll
                    for (int r = 0; r < 4; ++r) y[r] *= __expf(act[r]);
                    yacc[q] = y; } }
            __syncthreads();
            {
#pragma unroll
                for (int q = 0; q < 2; ++q) { const int pi = 2 * half + q;
#pragma unroll
                    for (int kk = 0; kk < 2; ++kk) if (2 * kk <= ti) yacc[q] = mfma16(*(const LAS bf16x8*)(wp + fr * ST64 + (kk * 32 + 8 * fq) * 2), *(const LAS bf16x8*)(lds + N_XDT + tsw(pi * 16 + fr, 4 * kk + fq)), yacc[q]); }
                const float ea = __expf(a_last);
                bf16x8 xa[2];
#pragma unroll
                for (int kk = 0; kk < 2; ++kk) xa[kk] = *(const LAS bf16x8*)(lds + N_XW + tsw(hp * 16 + fr, 4 * kk + fq));
#pragma unroll
                for (int q = 0; q < 4; ++q) { const int ni = 4 * half + q; f32x4 hv = hacc[q] * ea;
#pragma unroll
                    for (int kk = 0; kk < 2; ++kk) hv = mfma16(xa[kk], *(const LAS bf16x8*)(lds + N_BT + tsw(ni * 16 + fr, 4 * kk + fq)), hv);
                    hacc[q] = hv;
#pragma unroll
                    for (int r = 0; r < 4; ++r) *(LAS unsigned short*)(lds + N_HB + (hp * 16 + 4 * fq + r) * ST128 + (ni * 16 + fr) * 2) = f2bf(hv[r]); }
                __builtin_amdgcn_wave_barrier();
#pragma unroll
                for (int q = 0; q < 2; ++q)
#pragma unroll
                    for (int r = 0; r < 4; ++r) *(LAS float*)(wp + (4 * fq + r) * 144 + (16 * q + fr) * 4) = yacc[q][r];
                __builtin_amdgcn_wave_barrier();
                const int tl = lane >> 2, pq = lane & 3;
                const f32x4 y0 = *(const LAS f32x4*)(wp + tl * 144 + pq * 32), y1 = *(const LAS f32x4*)(wp + tl * 144 + pq * 32 + 16);
                const u32x4 xr = *(const LAS u32x4*)(lds + N_XS + (16 * ti + tl) * ST64 + (32 * half + 8 * pq) * 2);
                const float xs[8] = {bf_lo(xr.x), bf_hi(xr.x), bf_lo(xr.y), bf_hi(xr.y), bf_lo(xr.z), bf_hi(xr.z), bf_lo(xr.w), bf_hi(xr.w)};
                const float zz[8] = {bf_lo(zcur.x), bf_hi(zcur.x), bf_lo(zcur.y), bf_hi(zcur.y), bf_lo(zcur.z), bf_hi(zcur.z), bf_lo(zcur.w), bf_hi(zcur.w)};
                float gg[8];
#pragma unroll
                for (int e = 0; e < 8; ++e) { const float yv = (e < 4 ? y0[e & 3] : y1[e & 3]) + D_h * xs[e]; gg[e] = yv * silu_f(zz[e]); }
                u32x4 w; w.x = cvt_pk_bf16(gg[0], gg[1]); w.y = cvt_pk_bf16(gg[2], gg[3]); w.z = cvt_pk_bf16(gg[4], gg[5]); w.w = cvt_pk_bf16(gg[6], gg[7]);
                if (DUMMY) *(u32x4*)((bf16_t*)(p.ws + WS_END) + (size_t)(blockIdx.x * 64 + 16 * ti + tl) * 64 + 32 * half + 8 * pq) = w;
                else *(u32x4*)(Z + (size_t)(R + 16 * ti + tl) * 2048 + h * 64 + 32 * half + 8 * pq) = w; }
            __syncthreads();
        }
#undef SCAN_PREFETCH
#pragma unroll
        for (int q = 0; q < 4; ++q)
#pragma unroll
            for (int r = 0; r < 4; ++r) hout[(hp * 16 + 4 * fq + r) * 128 + (4 * half + q) * 16 + fr] = hacc[q][r];
    }
}

__device__ __forceinline__ void phase_gnorm(const Params& p) {
    const int wid = threadIdx.x >> 6, lane = threadIdx.x & 63; bf16_t* Z = (bf16_t*)p.out; const float* nw = p.in[10];
    for (int row = blockIdx.x * 8 + wid; row < T; row += gridDim.x * 8) {
        bf16_t* zr = Z + (size_t)row * 2048 + 8 * lane;
        u32x4 raw[4];
#pragma unroll
        for (int j = 0; j < 4; ++j) raw[j] = *(const u32x4*)(zr + 512 * j);
#pragma unroll
        for (int j = 0; j < 4; ++j) { const float v[8] = {bf_lo(raw[j].x), bf_hi(raw[j].x), bf_lo(raw[j].y), bf_hi(raw[j].y), bf_lo(raw[j].z), bf_hi(raw[j].z), bf_lo(raw[j].w), bf_hi(raw[j].w)};
            float ss = 0.f;
#pragma unroll
            for (int e = 0; e < 8; ++e) ss += v[e] * v[e];
#pragma unroll
            for (int o = 16; o >= 1; o >>= 1) ss += __shfl_xor(ss, o);
            const float sc = rsqrtf(ss * (1.0f / 256.0f) + LN_EPS);
            const f32x4 w0 = *(const f32x4*)(nw + 512 * j + 8 * lane), w1 = *(const f32x4*)(nw + 512 * j + 8 * lane + 4);
            u32x4 w; w.x = cvt_pk_bf16(v[0] * sc * w0[0], v[1] * sc * w0[1]); w.y = cvt_pk_bf16(v[2] * sc * w0[2], v[3] * sc * w0[3]); w.z = cvt_pk_bf16(v[4] * sc * w1[0], v[5] * sc * w1[1]); w.w = cvt_pk_bf16(v[6] * sc * w1[2], v[7] * sc * w1[3]);
            *(u32x4*)(zr + 512 * j) = w; }
    }
}

__device__ __forceinline__ void phase_ln(const float* src, const float* resS, const bf16_t* slabs, float* dstf, bf16_t* dstb, const float* gam, const float* bet) {
    const int wid = threadIdx.x >> 6, lane = threadIdx.x & 63;
    f32x4 gv[4], bv[4];
#pragma unroll
    for (int j = 0; j < 4; ++j) { gv[j] = *(const f32x4*)(gam + 256 * j + 4 * lane); bv[j] = *(const f32x4*)(bet + 256 * j + 4 * lane); }
    for (int row = blockIdx.x * 8 + wid; row < T; row += gridDim.x * 8) {
        f32x4 v[4]; float sum = 0.f;
        if (row < TP) { const float* sp = src + (size_t)row * 1024 + 4 * lane;
#pragma unroll
            for (int j = 0; j < 4; ++j) v[j] = *(const f32x4*)(sp + 256 * j); }
        else { const int r = row - TP; const float* rp = resS + (size_t)r * 1024 + 4 * lane; const bf16_t* sl = slabs + (size_t)((r >> 8) * 16) * 65536 + (r & 255) * 256 + 4 * lane;
#pragma unroll
            for (int j = 0; j < 4; ++j) { f32x4 a = *(const f32x4*)(rp + 256 * j) * DN_ALPHA;
#pragma unroll
                for (int k = 0; k < 4; ++k) { const u32x2 w = *(const u32x2*)(sl + (size_t)(j * 4 + k) * 65536); a += (f32x4){bf_lo(w.x), bf_hi(w.x), bf_lo(w.y), bf_hi(w.y)}; }
                v[j] = a; } }
#pragma unroll
        for (int j = 0; j < 4; ++j) sum += (v[j][0] + v[j][1]) + (v[j][2] + v[j][3]);
        const float mean = wave_sum(sum) * (1.0f / 1024.0f); float q = 0.f;
#pragma unroll
        for (int j = 0; j < 4; ++j) { const f32x4 d = v[j] - mean; q += (d[0] * d[0] + d[1] * d[1]) + (d[2] * d[2] + d[3] * d[3]); }
        const float rstd = rsqrtf(wave_sum(q) * (1.0f / 1024.0f) + LN_EPS);
#pragma unroll
        for (int j = 0; j < 4; ++j) { const f32x4 o = (v[j] - mean) * rstd * gv[j] + bv[j];
            *(f32x4*)(dstf + (size_t)row * 1024 + 4 * lane + 256 * j) = o;
            if (dstb) { u32x2 w; w.x = cvt_pk_bf16(o[0], o[1]); w.y = cvt_pk_bf16(o[2], o[3]); *(u32x2*)(dstb + (size_t)row * 1024 + 4 * lane + 256 * j) = w; } }
    }
}

__device__ __forceinline__ void phase_lnv(const Params& p) {
    const int wid = threadIdx.x >> 6, lane = threadIdx.x & 63; bf16_t* BIG = (bf16_t*)(p.ws + WS_BIG); const float* gam = p.in[14]; const float* bet = p.in[15]; float* vrows = p.out + O_VROWS;
    for (int row = blockIdx.x * 8 + wid; row < T; row += gridDim.x * 8) {
        bf16_t* vr = BIG + (size_t)row * 4096 + 2048 + 8 * lane; float v[4][8]; float sum = 0.f;
#pragma unroll
        for (int j = 0; j < 4; ++j) { const u32x4 r = *(const u32x4*)(vr + 512 * j);
            v[j][0] = bf_lo(r.x); v[j][1] = bf_hi(r.x); v[j][2] = bf_lo(r.y); v[j][3] = bf_hi(r.y); v[j][4] = bf_lo(r.z); v[j][5] = bf_hi(r.z); v[j][6] = bf_lo(r.w); v[j][7] = bf_hi(r.w);
#pragma unroll
            for (int e = 0; e < 8; ++e) sum += v[j][e]; }
        const float mean = wave_sum(sum) * (1.0f / 2048.0f); float q = 0.f;
#pragma unroll
        for (int j = 0; j < 4; ++j)
#pragma unroll
            for (int e = 0; e < 8; ++e) { const float d = v[j][e] - mean; q += d * d; }
        const float rstd = rsqrtf(wave_sum(q) * (1.0f / 2048.0f) + LN_EPS);
#pragma unroll
        for (int j = 0; j < 4; ++j) { const int c = 512 * j + 8 * lane;
            const f32x4 g0 = *(const f32x4*)(gam + c), g1 = *(const f32x4*)(gam + c + 4), b0 = *(const f32x4*)(bet + c), b1 = *(const f32x4*)(bet + c + 4);
            f32x4 o0, o1;
#pragma unroll
            for (int e = 0; e < 4; ++e) { o0[e] = (v[j][e] - mean) * rstd * g0[e] + b0[e]; o1[e] = (v[j][4 + e] - mean) * rstd * g1[e] + b1[e]; }
            u32x4 w; w.x = cvt_pk_bf16(o0[0], o0[1]); w.y = cvt_pk_bf16(o0[2], o0[3]); w.z = cvt_pk_bf16(o1[0], o1[1]); w.w = cvt_pk_bf16(o1[2], o1[3]);
            *(u32x4*)(vr + 512 * j) = w;
            if (row >= TP) { float* d = vrows + (size_t)(row - TP) * 2048 + c; *(f32x4*)d = o0; *(f32x4*)(d + 4) = o1; } }
    }
}

constexpr int SP_VT = 0, SP_WS = 69632, SP_SO = 0, SP_VST = 272, SP_SOST = 528;
template <bool DUMMY> __device__ __forceinline__ void phase_spatial(const Params& p, ldsp lds) {
    const int tid = threadIdx.x, wid = tid >> 6, lane = tid & 63, fr = lane & 15, fq = lane >> 4;
    bf16_t* BIG = (bf16_t*)(p.ws + WS_BIG); const float* wsp = p.in[16]; const float* bsp = p.in[17];
    for (int unit = blockIdx.x; unit < 1280; unit += gridDim.x) {
        int R, L, g;
        if (unit < 1024) { g = unit & 7; R = (unit >> 3) * 128; L = 128; } else { const int i = unit - 1024; g = i & 7; R = TP + (i >> 3) * 64; L = 64; }
        for (int idx = tid; idx < L * 32; idx += 512) { const int s = idx >> 5, c8 = (idx & 31) * 8; const u32x4 r = *(const u32x4*)(BIG + (size_t)(R + s) * 4096 + 2048 + g * 256 + c8);
            const unsigned wv[4] = {r.x, r.y, r.z, r.w};
#pragma unroll
            for (int e = 0; e < 4; ++e) { *(LAS unsigned short*)(lds + SP_VT + (c8 + 2 * e) * SP_VST + s * 2) = (unsigned short)(wv[e] & 0xffffu); *(LAS unsigned short*)(lds + SP_VT + (c8 + 2 * e + 1) * SP_VST + s * 2) = (unsigned short)(wv[e] >> 16); } }
        for (int idx = tid; idx < L * (L / 4); idx += 512) { const int t = idx / (L / 4), s0 = (idx % (L / 4)) * 4; const f32x4 w = *(const f32x4*)(wsp + (size_t)(g * 128 + t) * 128 + s0);
            u32x2 o; o.x = cvt_pk_bf16(s0 <= t ? w[0] : 0.f, s0 + 1 <= t ? w[1] : 0.f); o.y = cvt_pk_bf16(s0 + 2 <= t ? w[2] : 0.f, s0 + 3 <= t ? w[3] : 0.f);
            *(LAS u32x2*)(lds + SP_WS + t * SP_VST + s0 * 2) = o; }
        __syncthreads();
        const int nT = L / 16, nK = L / 32;
        f32x4 acc[8][2];
#pragma unroll
        for (int ti = 0; ti < 8; ++ti) { acc[ti][0] = (f32x4){0.f, 0.f, 0.f, 0.f}; acc[ti][1] = (f32x4){0.f, 0.f, 0.f, 0.f}; }
#pragma unroll
        for (int kk = 0; kk < 4; ++kk) if (kk < nK) {
            const bf16x8 b0 = *(const LAS bf16x8*)(lds + SP_VT + (wid * 32 + fr) * SP_VST + (kk * 32 + 8 * fq) * 2), b1 = *(const LAS bf16x8*)(lds + SP_VT + (wid * 32 + 16 + fr) * SP_VST + (kk * 32 + 8 * fq) * 2);
#pragma unroll
            for (int ti = 0; ti < 8; ++ti) if (ti < nT && 32 * kk <= 16 * ti + 15) { const bf16x8 a = *(const LAS bf16x8*)(lds + SP_WS + (ti * 16 + fr) * SP_VST + (kk * 32 + 8 * fq) * 2);
                acc[ti][0] = mfma16(a, b0, acc[ti][0]); acc[ti][1] = mfma16(a, b1, acc[ti][1]); } }
        __syncthreads();
#pragma unroll
        for (int ti = 0; ti < 8; ++ti) if (ti < nT) {
#pragma unroll
            for (int r = 0; r < 4; ++r) { const int t = ti * 16 + 4 * fq + r; const float bb = bsp[g * 128 + t];
                *(LAS unsigned short*)(lds + SP_SO + t * SP_SOST + (wid * 32 + fr) * 2) = f2bf(acc[ti][0][r] + bb); *(LAS unsigned short*)(lds + SP_SO + t * SP_SOST + (wid * 32 + 16 + fr) * 2) = f2bf(acc[ti][1][r] + bb); } }
        __syncthreads();
        for (int idx = tid; idx < L * 32; idx += 512) { const int t = idx >> 5, c8 = (idx & 31) * 8; bf16_t* up = BIG + (size_t)(R + t) * 4096 + g * 256 + c8;
            const u32x4 uu = *(const u32x4*)up; const u32x4 ss = *(const LAS u32x4*)(lds + SP_SO + t * SP_SOST + c8 * 2);
            u32x4 w; w.x = cvt_pk_bf16(bf_lo(uu.x) * bf_lo(ss.x), bf_hi(uu.x) * bf_hi(ss.x)); w.y = cvt_pk_bf16(bf_lo(uu.y) * bf_lo(ss.y), bf_hi(uu.y) * bf_hi(ss.y));
            w.z = cvt_pk_bf16(bf_lo(uu.z) * bf_lo(ss.z), bf_hi(uu.z) * bf_hi(ss.z)); w.w = cvt_pk_bf16(bf_lo(uu.w) * bf_lo(ss.w), bf_hi(uu.w) * bf_hi(ss.w));
            if (DUMMY) *(u32x4*)((bf16_t*)(p.ws + WS_END) + (size_t)blockIdx.x * 16384 + (t & 63) * 256 + c8) = w; else *(u32x4*)up = w; }
        __syncthreads();
    }
}

__global__ void __launch_bounds__(512, 2) fwd_kernel(Params p) {
    extern __shared__ __attribute__((aligned(16))) unsigned char smem[];
    ldsp lds = (ldsp)smem;
    cg::grid_group grid = cg::this_grid();
    if (threadIdx.x < 4) ((LAS unsigned*)(lds + LDS_BARST))[threadIdx.x] = 0u;
    __syncthreads();
    XcdBarrier bar; bar.bar = (unsigned*)(p.ws + WS_BAR); bar.x = 0; bar.st = (volatile LAS unsigned*)(lds + LDS_BARST);
    if (p.ph_hi > p.ph_lo) bar = xcd_barrier_post((unsigned*)(p.ws + WS_BAR), (volatile LAS unsigned*)(lds + LDS_BARST));
    unsigned char* ws = p.ws; const int G = gridDim.x, bid = blockIdx.x;
    bf16_t* XB = (bf16_t*)(ws + WS_XB); bf16_t* BIG = (bf16_t*)(ws + WS_BIG); float* Y = p.out; bf16_t* Zb = (bf16_t*)p.out; bf16_t* SLAB = (bf16_t*)(ws + WS_SLAB);
#ifndef REPMASK
#define REPMASK 0
#endif
#define RUN(k) (((PHMASK >> (k)) & 1) && p.ph_lo <= (k) && (k) <= p.ph_hi)
#define DO2(k, ...) do { if ((REPMASK >> (k)) & 1) { __VA_ARGS__ } __VA_ARGS__ } while (0)
#if USE_CG_SYNC
#define SEAM(k) do { if (p.ph_lo <= (k) && (k) < p.ph_hi) grid.sync(); } while (0)
#else
#define SEAM(k) do { if (p.ph_lo <= (k) && (k) < p.ph_hi) xcd_barrier(bar); } while (0)
#endif
    if (RUN(0)) DO2(0, { phase_prep(p, lds); });
    SEAM(0);
    if (RUN(1)) DO2(1, { pg8::Gemm g{XB, (const bf16_t*)(ws + WS_WIN), T, 6144, 1024, 1024}; pg8::StaticOrder S; S.init(T, 6144, G, bid, 1024);
        pg8::EpiG1 E{Zb, BIG};
        pg8::gemm_phase<pg8::EpiG1, pg8::StaticOrder, true, true>(lds, g, S, E);
        phase_dt(p); });
    SEAM(1);
    if (RUN(1)) phase_conv(p, bar);
    if (p.ph_lo <= 1 && 1 <= p.ph_hi) { if (p.ph_hi > 1) xcd_barrier(bar); }
#ifdef PROBE_SCAN2
    if (RUN(2)) phase_scan<true>(p, lds);
#endif
    if (RUN(2)) phase_scan<false>(p, lds);
    SEAM(2);
    if (RUN(3)) phase_gnorm(p);
    SEAM(3);
    if (RUN(4)) DO2(4, { pg8::Gemm g{Zb, (const bf16_t*)(ws + WS_WOUT), T, 1024, 2048, 2048}; pg8::SplitOrder S; S.init(G, bid, 2048);
        pg8::EpiRes E{p.in[0], p.in[1], (float*)(ws + WS_BIG), DN_ALPHA, SLAB};
        pg8::gemm_phase<pg8::EpiRes, pg8::SplitOrder, true, true>(lds, g, S, E); });
    SEAM(4);
    if (RUN(5)) DO2(5, { phase_ln((const float*)(ws + WS_BIG), p.in[1], SLAB, Y, XB, p.in[21], p.in[22]); });
    SEAM(5);
    if (RUN(6)) DO2(6, { pg8::Gemm g{XB, (const bf16_t*)(ws + WS_W1), T, 4096, 1024, 1024}; pg8::StaticOrder S; S.init(T, 4096, G, bid, 1024);
        pg8::EpiAct<1> E{BIG, 4096, nullptr};
        pg8::gemm_phase<pg8::EpiAct<1>, pg8::StaticOrder, true, true>(lds, g, S, E); });
    SEAM(6);
    if (RUN(7)) { pg8::Gemm g{BIG, (const bf16_t*)(ws + WS_W2), T, 1024, 4096, 4096}; pg8::SplitOrder S; S.init(G, bid, 4096);
        pg8::EpiRes E{Y, Y + (size_t)TP * 1024, Y, DN_ALPHA, SLAB};
        pg8::gemm_phase<pg8::EpiRes, pg8::SplitOrder, true, true>(lds, g, S, E); }
    SEAM(7);
    if (RUN(8)) phase_ln(Y, Y + (size_t)TP * 1024, SLAB, Y, XB, p.in[23], p.in[24]);
    SEAM(8);
    if (RUN(9)) DO2(9, { pg8::Gemm g{XB, (const bf16_t*)(ws + WS_CMWIN), T, 4096, 1024, 1024}; pg8::StaticOrder S; S.init(T, 4096, G, bid, 1024);
        pg8::EpiAct<2> E{BIG, 4096, p.in[13]};
        pg8::gemm_phase<pg8::EpiAct<2>, pg8::StaticOrder, true, true>(lds, g, S, E); });
    SEAM(9);
    if (RUN(10)) phase_lnv(p);
    SEAM(10);
#ifdef PROBE_SPATIAL2
    if (RUN(11)) phase_spatial<true>(p, lds);
#endif
    if (RUN(11)) phase_spatial<false>(p, lds);
#ifdef PROBE_SYNC
    for (int i_ = 0; i_ < 16; ++i_) grid.sync();
#endif
    SEAM(11);
    if (RUN(12)) { pg8::Gemm g{BIG, (const bf16_t*)(ws + WS_CMWOUT), T, 1024, 2048, 4096}; pg8::SplitOrder S; S.init(G, bid, 2048);
        pg8::EpiRes E{Y, Y + (size_t)TP * 1024, Y, DN_ALPHA, SLAB};
        pg8::gemm_phase<pg8::EpiRes, pg8::SplitOrder, true, true>(lds, g, S, E); }
    SEAM(12);
    if (RUN(13)) phase_ln(Y, Y + (size_t)TP * 1024, SLAB, Y, XB, p.in[21] + 1024, p.in[22] + 1024);
    SEAM(13);
    if (RUN(14)) DO2(14, { pg8::Gemm g{XB, (const bf16_t*)(ws + WS_W1) + (size_t)4096 * 1024, T, 4096, 1024, 1024}; pg8::StaticOrder S; S.init(T, 4096, G, bid, 1024);
        pg8::EpiAct<1> E{BIG, 4096, nullptr};
        pg8::gemm_phase<pg8::EpiAct<1>, pg8::StaticOrder, true, true>(lds, g, S, E); });
    SEAM(14);
    if (RUN(15)) { pg8::Gemm g{BIG, (const bf16_t*)(ws + WS_W2) + (size_t)4096 * 1024, T, 1024, 4096, 4096}; pg8::SplitOrder S; S.init(G, bid, 4096);
        pg8::EpiRes E{Y, Y + (size_t)TP * 1024, Y, DN_ALPHA, SLAB};
        pg8::gemm_phase<pg8::EpiRes, pg8::SplitOrder, true, true>(lds, g, S, E); }
    SEAM(15);
    if (RUN(16)) phase_ln(Y, Y + (size_t)TP * 1024, SLAB, Y, nullptr, p.in[23] + 1024, p.in[24] + 1024);
    if (p.ph_lo > 1000) grid.sync();
}

#ifndef ONE_LAUNCH
#define ONE_LAUNCH 0
#endif
extern "C" void kernel_launch(void* const* d_in, const int* in_sizes, int n_in, void* d_out, int out_size, void* d_ws, size_t ws_size, hipStream_t stream) {
    static int grid = 0;
    if (grid == 0) {
        if (n_in != 25 || ws_size < WS_NEED) { fprintf(stderr, "kernel_launch: unexpected n_in %d / ws_size %zu\n", n_in, ws_size); grid = -1; return; }
        int dev = 0, cus = 0, per_cu = 0;
        hipGetDevice(&dev); hipDeviceGetAttribute(&cus, hipDeviceAttributeMultiprocessorCount, dev);
        if (hipFuncSetAttribute((const void*)fwd_kernel, hipFuncAttributeMaxDynamicSharedMemorySize, LDS_BYTES) != hipSuccess) { fprintf(stderr, "kernel_launch: hipFuncSetAttribute failed\n"); grid = -1; return; }
        hipOccupancyMaxActiveBlocksPerMultiprocessor(&per_cu, (const void*)fwd_kernel, 512, LDS_BYTES);
        if (per_cu < 1) { fprintf(stderr, "kernel_launch: occupancy query says %d blocks per CU\n", per_cu); per_cu = 1; }
        (void)hipGetLastError();
        grid = cus;
        if (grid != 256) { fprintf(stderr, "kernel_launch: built for a 256-CU device (got %d)\n", cus); grid = -1; return; }
    }
    if (grid < 0) return;
    if (hipMemsetAsync((char*)d_ws + WS_BAR, 0, 16384, stream) != hipSuccess) { fprintf(stderr, "kernel_launch: memset failed\n"); return; }
    Params p{};
    for (int i = 0; i < 25; ++i) p.in[i] = (const float*)d_in[i];
    p.out = (float*)d_out; p.ws = (unsigned char*)d_ws;
#if ONE_LAUNCH
    p.ph_lo = 0; p.ph_hi = NPHASE - 1;
    void* args[] = {&p};
    hipError_t e = hipLaunchCooperativeKernel((const void*)fwd_kernel, dim3(grid), dim3(512), args, LDS_BYTES, stream);
    if (e != hipSuccess) fprintf(stderr, "cooperative launch failed: %s (grid %d)\n", hipGetErrorString(e), grid);
#else
    for (int ph = 0; ph < NPHASE; ++ph) { p.ph_lo = ph; p.ph_hi = ph; hipLaunchKernelGGL(fwd_kernel, dim3(grid), dim3(512), LDS_BYTES, stream, p); }
#endif
}
```

```cpp
#include <hip/hip_runtime.h>
#include <hip/hip_cooperative_groups.h>
#include <cstdio>
#include <cstdint>
namespace cg = cooperative_groups;
#ifndef PHMASK
#define PHMASK 0x1ffff
#endif
#ifndef USE_CG_SYNC
#define USE_CG_SYNC 0
#endif
#ifndef PROBE_NOCONV
#define PROBE_NOCONV 0
#endif
#ifndef ONE_LAUNCH
#define ONE_LAUNCH 1
#endif
namespace pg8 {
#define PG8_LAS __attribute__((address_space(3)))
typedef unsigned short bf16_t;
typedef short bf16x8 __attribute__((ext_vector_type(8)));
typedef float f32x4 __attribute__((ext_vector_type(4)));
typedef unsigned u32x4 __attribute__((ext_vector_type(4)));
constexpr int BM = 256, BK = 64, HALF = 128, HTB = HALF * BK * 2  , STAGE_BYTES = 8 * HTB, NXCD = 8, WGM = 8;

__host__ __device__ __forceinline__ int lds_byte(int r, int c) { const int st = (r >> 4) * 2 + (c >> 5), rr = r & 15, cc = c & 31, ob = rr * 64 + cc * 2; return st * 1024 + (ob ^ (((ob >> 9) & 1) << 5)); }
__host__ __device__ __forceinline__ void stage_rc(int b, int& R, int& C) { const int st = b / 1024, sb = b % 1024, swz = sb ^ (((sb >> 9) & 1) << 5); R = (st >> 1) * 16 + swz / 64; C = (st & 1) * 32 + (swz % 64) / 2; }
__host__ __device__ __forceinline__ int perm32(int rho) { const int n = rho >> 4, i = rho & 15; return 8 * (i >> 2) + 4 * n + (i & 3); }

struct Unit { int pm, pn, kofs, nt, slab; };
struct Gemm { const bf16_t* A; const bf16_t* Bt; int M, N, K, lda; };

struct StaticOrder {
    int nM, nN, nwg, G, c, nt;
    __host__ __device__ void init(int M, int N, int G_, int c_, int K_) { nM = M / BM; nN = N / BM; nwg = nM * nN; G = G_; c = c_; nt = K_ / BK; }
    __host__ __device__ bool next(int i, Unit& u) const {
        const long L = (long)i * G + c; if (L >= nwg) return false;
        int wgid = (int)L; { const int q = nwg / NXCD, r = nwg % NXCD, xcd = wgid % NXCD, off = wgid / NXCD; wgid = (xcd < r ? xcd * (q + 1) : r * (q + 1) + (xcd - r) * q) + off; }
        const int nig = WGM * nN, gid = wgid / nig, fm = gid * WGM, gsz = (nM - fm) < WGM ? (nM - fm) : WGM;
        u.pm = fm + ((wgid % nig) % gsz); u.pn = (wgid % nig) / gsz; u.kofs = 0; u.nt = nt; u.slab = -1; return true;
    }
    __device__ __forceinline__ void a_ready(const Unit&) const {}
    __device__ __forceinline__ void done(const Unit&) const {}
};
__device__ __forceinline__ unsigned cvt_pk_bf16(float lo, float hi) { unsigned r; asm volatile("v_cvt_pk_bf16_f32 %0, %1, %2" : "=v"(r) : "v"(lo), "v"(hi)); return r; }

constexpr int TP_ROWS = 16384;
typedef unsigned u32x2 __attribute__((ext_vector_type(2)));
struct EpiG1 {
    static constexpr bool PERM = true, AFTER_DRAIN = false;
    bf16_t* Z; bf16_t* XBC; bf16_t* BND;
    __device__ __forceinline__ void operator()(const f32x4 (&acc)[2][2][4][2], const Unit& u, int wr, int wc, int fr, int fq) const {
        const int row0 = u.pm * BM + wr * 64 + fr; const int colt = u.pn * BM;
        const bool isx = colt >= 2048;
        bf16_t* base = isx ? XBC : Z; const int ldc = isx ? 4096 : 2048; const int col0 = (isx ? colt - 2048 : colt) + wc * 32 + 8 * fq;
#pragma unroll
        for (int ai = 0; ai < 2; ++ai)
#pragma unroll
            for (int m = 0; m < 4; ++m) { bf16_t* rowp = base + (size_t)(row0 + ai * HALF + m * 16) * ldc + col0;
#pragma unroll
                for (int bj = 0; bj < 2; ++bj) { const f32x4 v0 = acc[ai][bj][m][0], v1 = acc[ai][bj][m][1];
                    u32x4 w; w.x = cvt_pk_bf16(v0[0], v0[1]); w.y = cvt_pk_bf16(v0[2], v0[3]); w.z = cvt_pk_bf16(v1[0], v1[1]); w.w = cvt_pk_bf16(v1[2], v1[3]);
                    *(u32x4*)(rowp + bj * HALF) = w;
                    if (m == 3 && isx && fr >= 13) *(u32x4*)(BND + (size_t)(((row0 + ai * HALF) >> 6) * 3 + (fr - 13)) * 4096 + col0 + bj * HALF) = w; } }
    }
};
__device__ __forceinline__ float act_relu2(float v) { const float r = v > 0.f ? v : 0.f; return r * r; }
__device__ __forceinline__ float act_gelu_tanh(float v) { const float u = 0.7978845608f * (v + 0.044715f * v * v * v); return v * __builtin_amdgcn_rcpf(1.0f + __expf(-2.0f * u)); }
template <int ACT> struct EpiAct {
    static constexpr bool PERM = true, AFTER_DRAIN = false;
    bf16_t* O; int ldc; const float* bias; float* vstat;
    __device__ __forceinline__ void operator()(const f32x4 (&acc)[2][2][4][2], const Unit& u, int wr, int wc, int fr, int fq) const {
        const int row0 = u.pm * BM + wr * 64 + fr; const int col0 = u.pn * BM + wc * 32 + 8 * fq;
        const bool dostat = (ACT == 2) && u.pn >= 8;
        f32x4 bv[2][2];
#pragma unroll
        for (int bj = 0; bj < 2; ++bj)
#pragma unroll
            for (int n = 0; n < 2; ++n) bv[bj][n] = (ACT == 2) ? *(const f32x4*)(bias + col0 + bj * HALF + 4 * n) : (f32x4){0.f, 0.f, 0.f, 0.f};
#pragma unroll
        for (int ai = 0; ai < 2; ++ai)
#pragma unroll
            for (int m = 0; m < 4; ++m) { bf16_t* rowp = O + (size_t)(row0 + ai * HALF + m * 16) * ldc + col0; float s1 = 0.f, s2 = 0.f;
#pragma unroll
                for (int bj = 0; bj < 2; ++bj) { f32x4 v0 = acc[ai][bj][m][0] + bv[bj][0], v1 = acc[ai][bj][m][1] + bv[bj][1];
#pragma unroll
                    for (int j = 0; j < 4; ++j) { if (ACT == 1) { v0[j] = act_relu2(v0[j]); v1[j] = act_relu2(v1[j]); } else { v0[j] = act_gelu_tanh(v0[j]); v1[j] = act_gelu_tanh(v1[j]); } }
                    if (ACT == 2) {
#pragma unroll
                        for (int j = 0; j < 4; ++j) { s1 += v0[j] + v1[j]; s2 += v0[j] * v0[j] + v1[j] * v1[j]; } }
                    u32x4 w; w.x = cvt_pk_bf16(v0[0], v0[1]); w.y = cvt_pk_bf16(v0[2], v0[3]); w.z = cvt_pk_bf16(v1[0], v1[1]); w.w = cvt_pk_bf16(v1[2], v1[3]);
                    *(u32x4*)(rowp + bj * HALF) = w; }
                if (ACT == 2) { if (dostat) { s1 += __shfl_xor(s1, 16); s2 += __shfl_xor(s2, 16); s1 += __shfl_xor(s1, 32); s2 += __shfl_xor(s2, 32);
                    if (fq == 0) { float* d = vstat + (size_t)(row0 + ai * HALF + m * 16) * 2; atomicAdd(d, s1); atomicAdd(d + 1, s2); } } } }
    }
};
struct EpiRes {
    static constexpr bool PERM = false, AFTER_DRAIN = false;
    const float* resP; const float* resS; float* out; float alpha; bf16_t* slabs;
    __device__ __forceinline__ void operator()(const f32x4 (&acc)[2][2][4][2], const Unit& u, int wr, int wc, int fr, int fq) const {
        if (u.slab >= 0) { bf16_t* sp = slabs + (size_t)u.slab * 65536 + (wr * 64 + fr) * 256 + wc * 32 + 4 * fq;
#pragma unroll
            for (int ai = 0; ai < 2; ++ai)
#pragma unroll
                for (int m = 0; m < 4; ++m)
#pragma unroll
                    for (int bj = 0; bj < 2; ++bj)
#pragma unroll
                        for (int n = 0; n < 2; ++n) { const f32x4 v = acc[ai][bj][m][n]; u32x2 w; w.x = cvt_pk_bf16(v[0], v[1]); w.y = cvt_pk_bf16(v[2], v[3]); *(u32x2*)(sp + (ai * HALF + m * 16) * 256 + bj * HALF + n * 16) = w; }
            return; }
        const int row0 = u.pm * BM + wr * 64 + fr, col0 = u.pn * BM + wc * 32 + 4 * fq;
#pragma unroll
        for (int ai = 0; ai < 2; ++ai)
#pragma unroll
            for (int m = 0; m < 4; ++m) { const int row = row0 + ai * HALF + m * 16;
                const float* rp = (row < TP_ROWS ? resP + (size_t)row * 1024 : resS + (size_t)(row - TP_ROWS) * 1024) + col0; float* op = out + (size_t)row * 1024 + col0;
#pragma unroll
                for (int bj = 0; bj < 2; ++bj)
#pragma unroll
                    for (int n = 0; n < 2; ++n) { const f32x4 r = *(const f32x4*)(rp + bj * HALF + n * 16); *(f32x4*)(op + bj * HALF + n * 16) = r * alpha + acc[ai][bj][m][n]; } }
    }
};
struct SplitOrder {
    StaticOrder so; int K, c;
    __device__ void init(int G_, int c_, int K_) { so.init(TP_ROWS, 1024, G_, c_, K_); K = K_; c = c_; }
    __device__ bool next(int i, Unit& u) const {
        if (i == 0) return so.next(0, u);
        if (i == 1 && c < 128) { u.pm = 64 + (c >> 4); u.pn = (c >> 2) & 3; u.kofs = (c & 3) * (K >> 2); u.nt = K >> 8; u.slab = c; return true; }
        return false; }
    __device__ __forceinline__ void a_ready(const Unit&) const {}
    __device__ __forceinline__ void done(const Unit&) const {}
};
template <class Epi, class Sched, bool ALIGN_EPI = false, bool SP2 = false>
__device__ __forceinline__ void gemm_phase(PG8_LAS unsigned char* lds, const Gemm g, const Sched& S, const Epi& E) {
    const int tid = threadIdx.x, wid = __builtin_amdgcn_readfirstlane(tid >> 6), lane = tid & 63, wr = wid >> 2, wc = wid & 3, fr = lane & 15, fq = lane >> 4;
    const int K = g.K;
    unsigned voffA[2], voffB[2];
#pragma unroll
    for (int i = 0; i < 2; ++i) { int R, C; stage_rc(tid * 16 + i * 8192, R, C); const int Rb = Epi::PERM ? ((R & ~31) + perm32(R & 31)) : R;
        voffA[i] = (unsigned)(R * g.lda + C) * 2u; voffB[i] = (unsigned)(Rb * K + C) * 2u; }
    const size_t kstep = (size_t)(BK * 2);
    const size_t hstepA = (size_t)HALF * g.lda * 2, hstepB = (size_t)HALF * K * 2;
    const size_t tstepA = 2 * hstepA, tstepB = 2 * hstepB;
    const unsigned ldsw = (unsigned)wid * 1024u;
    const int aoff = lds_byte(wr * 64 + fr, fq * 8), boff = lds_byte(wc * 32 + fr, fq * 8);
#define PG8_SA(b, h) (((b) * 2 + (h)) * HTB)
#define PG8_SB(b, h) ((4 + (b) * 2 + (h)) * HTB)
#define PG8_STAGE(bufoff, gbase, voff) do { _Pragma("unroll") for (int _i = 0; _i < 2; ++_i) \
        __builtin_amdgcn_global_load_lds((const unsigned*)((const char*)(gbase) + (voff)[_i]), (PG8_LAS unsigned*)(lds + (bufoff) + ldsw + _i * 8192), 16, 0, 0); } while (0)
#define PG8_LDA(dst, b, h) do { _Pragma("unroll") for (int m = 0; m < 4; ++m) _Pragma("unroll") for (int k = 0; k < 2; ++k) dst[m][k] = *(const PG8_LAS bf16x8*)(lds + PG8_SA(b, h) + aoff + m * 2048 + k * 1024); } while (0)
#define PG8_LDB(dst, b, h) do { _Pragma("unroll") for (int n = 0; n < 2; ++n) _Pragma("unroll") for (int k = 0; k < 2; ++k) dst[n][k] = *(const PG8_LAS bf16x8*)(lds + PG8_SB(b, h) + boff + n * 2048 + k * 1024); } while (0)
#define PG8_MMA(ai, bj, At, Bt) do { __builtin_amdgcn_s_setprio(1); _Pragma("unroll") for (int m = 0; m < 4; ++m) _Pragma("unroll") for (int n = 0; n < 2; ++n) _Pragma("unroll") for (int k = 0; k < 2; ++k) \
        acc[ai][bj][m][n] = __builtin_amdgcn_mfma_f32_16x16x32_bf16(Bt[n][k], At[m][k], acc[ai][bj][m][n], 0, 0, 0); __builtin_amdgcn_s_setprio(0); } while (0)
#define PG8_WAIT_V(n) asm volatile("s_waitcnt vmcnt(" #n ")" ::: "memory")
#define PG8_WAIT_L(n) asm volatile("s_waitcnt lgkmcnt(" #n ")" ::: "memory")
#define PG8_BAR __builtin_amdgcn_s_barrier()
#define PG8_SCHED __builtin_amdgcn_sched_barrier(0)
    Unit cur, nxt; int ui = 0;
    if (!S.next(0, cur)) return;
    f32x4 acc[2][2][4][2];
#pragma unroll
    for (int a = 0; a < 2; ++a)
#pragma unroll
        for (int b = 0; b < 2; ++b)
#pragma unroll
            for (int m = 0; m < 4; ++m)
#pragma unroll
                for (int n = 0; n < 2; ++n) acc[a][b][m][n] = (f32x4){0.f, 0.f, 0.f, 0.f};
    bf16x8 At[4][2], B0[2][2], B1[2][2];
    const char* cA = (const char*)g.A + (size_t)cur.pm * tstepA + (size_t)cur.kofs * 2; const char* cB = (const char*)g.Bt + (size_t)cur.pn * tstepB + (size_t)cur.kofs * 2;
    S.a_ready(cur);
    if constexpr (SP2) {
        PG8_STAGE(PG8_SB(0, 0), cB, voffB); PG8_STAGE(PG8_SB(0, 1), cB + hstepB, voffB); PG8_STAGE(PG8_SA(0, 0), cA, voffA); PG8_STAGE(PG8_SA(0, 1), cA + hstepA, voffA);
        if (wr == 1) PG8_BAR;
        PG8_WAIT_V(2); PG8_BAR;
        PG8_STAGE(PG8_SB(1, 0), cB + kstep, voffB); PG8_STAGE(PG8_SA(1, 0), cA + kstep, voffA); PG8_STAGE(PG8_SB(1, 1), cB + hstepB + kstep, voffB);
        PG8_WAIT_V(6); PG8_BAR;
    } else {
        PG8_STAGE(PG8_SB(0, 0), cB, voffB); PG8_STAGE(PG8_SA(0, 0), cA, voffA); PG8_STAGE(PG8_SB(0, 1), cB + hstepB, voffB); PG8_STAGE(PG8_SA(0, 1), cA + hstepA, voffA);
        if (wr == 1) PG8_BAR;
        PG8_WAIT_V(4); PG8_BAR;
        PG8_STAGE(PG8_SB(1, 0), cB + kstep, voffB); PG8_STAGE(PG8_SA(1, 0), cA + kstep, voffA); PG8_STAGE(PG8_SB(1, 1), cB + hstepB + kstep, voffB);
        PG8_WAIT_V(6); PG8_BAR;
    }
    for (;;) {
        const bool has_next = S.next(ui + 1, nxt);
        const char* nA = has_next ? (const char*)g.A + (size_t)nxt.pm * tstepA + (size_t)nxt.kofs * 2 : cA; const char* nB = has_next ? (const char*)g.Bt + (size_t)nxt.pn * tstepB + (size_t)nxt.kofs * 2 : cB;
        const int nt = cur.nt;
        for (int t = 0; t < nt; t += 2) {
            const bool last = (t == nt - 2);
            const char* a1 = cA + (size_t)(t + 1) * kstep;
            const char* a2 = last ? nA : cA + (size_t)(t + 2) * kstep; const char* b2 = last ? nB : cB + (size_t)(t + 2) * kstep;
            const char* a3 = a2 + kstep; const char* b3 = b2 + kstep;
            if (last && has_next) S.a_ready(nxt);
            if constexpr (SP2) {
            PG8_LDB(B0, 0, 0); PG8_LDB(B1, 0, 1); PG8_SCHED; PG8_LDA(At, 0, 0); PG8_STAGE(PG8_SA(1, 1), a1 + hstepA, voffA);
            PG8_WAIT_V(8); PG8_WAIT_L(0); PG8_BAR; PG8_MMA(0, 0, At, B0); PG8_MMA(0, 1, At, B1); PG8_BAR; PG8_SCHED;
            PG8_LDA(At, 0, 1); PG8_STAGE(PG8_SB(0, 0), b2, voffB); PG8_STAGE(PG8_SB(0, 1), b2 + hstepB, voffB); PG8_STAGE(PG8_SA(0, 0), a2, voffA);
            PG8_WAIT_V(8); PG8_WAIT_L(0); PG8_BAR; PG8_MMA(1, 0, At, B0); PG8_MMA(1, 1, At, B1); PG8_BAR; PG8_SCHED;
            PG8_LDB(B0, 1, 0); PG8_LDB(B1, 1, 1); PG8_SCHED; PG8_LDA(At, 1, 0); PG8_STAGE(PG8_SA(0, 1), a2 + hstepA, voffA);
            PG8_WAIT_V(8); PG8_WAIT_L(0); PG8_BAR; PG8_MMA(0, 0, At, B0); PG8_MMA(0, 1, At, B1); PG8_BAR; PG8_SCHED;
            PG8_LDA(At, 1, 1); PG8_STAGE(PG8_SB(1, 0), b3, voffB); PG8_STAGE(PG8_SB(1, 1), b3 + hstepB, voffB); PG8_STAGE(PG8_SA(1, 0), a3, voffA);
            PG8_WAIT_V(8); PG8_WAIT_L(0); PG8_BAR; PG8_MMA(1, 0, At, B0); PG8_MMA(1, 1, At, B1); PG8_BAR; PG8_SCHED;
            } else {
            PG8_LDB(B0, 0, 0); PG8_SCHED; PG8_LDA(At, 0, 0); PG8_STAGE(PG8_SA(1, 1), a1 + hstepA, voffA);
            PG8_WAIT_L(8); PG8_BAR; PG8_WAIT_L(0); PG8_MMA(0, 0, At, B0); PG8_BAR; PG8_SCHED;
            PG8_LDB(B1, 0, 1); PG8_STAGE(PG8_SB(0, 0), b2, voffB);
            PG8_BAR; PG8_WAIT_L(0); PG8_MMA(0, 1, At, B1); PG8_BAR;
            PG8_LDA(At, 0, 1); PG8_STAGE(PG8_SA(0, 0), a2, voffA);
            PG8_BAR; PG8_WAIT_L(0); PG8_MMA(1, 0, At, B0); PG8_BAR; PG8_SCHED;
            PG8_STAGE(PG8_SB(0, 1), b2 + hstepB, voffB);
            PG8_WAIT_V(6); PG8_BAR; PG8_MMA(1, 1, At, B1); PG8_BAR;
            PG8_LDB(B0, 1, 0); PG8_SCHED; PG8_LDA(At, 1, 0); PG8_STAGE(PG8_SA(0, 1), a2 + hstepA, voffA);
            PG8_WAIT_L(8); PG8_BAR; PG8_WAIT_L(0); PG8_MMA(0, 0, At, B0); PG8_BAR; PG8_SCHED;
            PG8_LDB(B1, 1, 1); PG8_STAGE(PG8_SB(1, 0), b3, voffB);
            PG8_BAR; PG8_WAIT_L(0); PG8_MMA(0, 1, At, B1); PG8_BAR;
            PG8_LDA(At, 1, 1); PG8_STAGE(PG8_SA(1, 0), a3, voffA);
            PG8_BAR; PG8_WAIT_L(0); PG8_MMA(1, 0, At, B0); PG8_BAR; PG8_SCHED;
            PG8_STAGE(PG8_SB(1, 1), b3 + hstepB, voffB);
            PG8_WAIT_V(6); PG8_BAR; PG8_MMA(1, 1, At, B1); PG8_BAR;
            }
        }
        if constexpr (ALIGN_EPI) { if (wr == 0) PG8_BAR; }
        if constexpr (!Epi::AFTER_DRAIN) { E(acc, cur, wr, wc, fr, fq); S.done(cur); }
        if (!has_next) break;
#pragma unroll
        for (int a = 0; a < 2; ++a)
#pragma unroll
            for (int b = 0; b < 2; ++b)
#pragma unroll
                for (int m = 0; m < 4; ++m)
#pragma unroll
                    for (int n = 0; n < 2; ++n) acc[a][b][m][n] = (f32x4){0.f, 0.f, 0.f, 0.f};
        cur = nxt; cA = nA; cB = nB; ++ui;
        if constexpr (ALIGN_EPI) { if (wr == 1) PG8_BAR; }
    }
    PG8_WAIT_V(0);
    if constexpr (!ALIGN_EPI) { if (wr == 0) PG8_BAR; }
    PG8_BAR;
    if constexpr (Epi::AFTER_DRAIN) { E.fused(acc, cur, wr, wc, fr, fq, lds, wid, lane); S.done(cur); }
#undef PG8_SA
#undef PG8_SB
#undef PG8_STAGE
#undef PG8_LDA
#undef PG8_LDB
#undef PG8_MMA
#undef PG8_WAIT_V
#undef PG8_WAIT_L
#undef PG8_BAR
#undef PG8_SCHED
}
}

#define LAS __attribute__((address_space(3)))
typedef LAS unsigned char* ldsp;
using pg8::bf16_t; using pg8::bf16x8; using pg8::f32x4; using pg8::u32x4; using pg8::cvt_pk_bf16;
using pg8::u32x2;

#define XB_TMO      128
#define XB_XCNT(j)  (256  + 64 * (j))
#define XB_XSUB(j)  (1280 + 64 * (j))
#define XB_XGEN(j)  (2304 + 64 * (j))
#define XB_TOP      3328
#define XB_TOPGEN   3392
#define XCD_BAR_WORDS 3456
#define XB_SPIN_CAP (1u << 18)

__device__ __forceinline__ unsigned xb_ld(unsigned* p)              { return __hip_atomic_load(p, __ATOMIC_RELAXED, __HIP_MEMORY_SCOPE_AGENT); }
__device__ __forceinline__ unsigned xb_add(unsigned* p, unsigned v) { return __hip_atomic_fetch_add(p, v, __ATOMIC_RELAXED, __HIP_MEMORY_SCOPE_AGENT); }
__device__ __forceinline__ unsigned xb_xcc_id() { return (unsigned)__builtin_amdgcn_s_getreg((3 << 11) | 20) & 0xFu; }
#define XB_SPIN(cond, bar) do { unsigned _sp = 0; while (cond) { __builtin_amdgcn_s_sleep(1); \
    if ((++_sp & 255u) == 0u) { if (xb_ld(&(bar)[XB_TMO])) break; if (_sp > XB_SPIN_CAP) { atomicAdd(&(bar)[XB_TMO], 1u); break; } } } } while (0)

struct XcdBarrier {
    unsigned* bar; unsigned x;
    volatile LAS unsigned* st;
};

__device__ __forceinline__ XcdBarrier xcd_barrier_post(unsigned* bar, volatile LAS unsigned* st) {
    XcdBarrier b; b.bar = bar; b.x = xb_xcc_id(); b.st = st;
    if (threadIdx.x == 0) (void)xb_add(&bar[XB_XCNT(b.x)], 1u);
    return b;
}
__device__ __forceinline__ void xcd_barrier_complete(unsigned* bar, unsigned x, unsigned& nloc, unsigned& nx) {
    const unsigned G = gridDim.x * gridDim.y * gridDim.z;
    unsigned sum, cnt, mine, sp = 0u;
    for (;;) {
        sum = 0u; cnt = 0u; mine = 0u;
#pragma unroll
        for (unsigned j = 0; j < 16; ++j) { const unsigned c = xb_ld(&bar[XB_XCNT(j)]); sum += c; cnt += (c > 0u) ? 1u : 0u; mine = (j == x) ? c : mine; }
        if (sum == G) break;
        __builtin_amdgcn_s_sleep(1);
        if ((++sp & 255u) == 0u) { if (xb_ld(&bar[XB_TMO])) break; if (sp > XB_SPIN_CAP) { atomicAdd(&bar[XB_TMO], 1u); break; } }
    }
    nloc = mine > 0u ? mine : 1u; nx = cnt > 0u ? cnt : 1u;
}

__device__ __forceinline__ void xcd_barrier(const XcdBarrier& b) {
    asm volatile("s_waitcnt vmcnt(0)" ::: "memory");
    __syncthreads();
    if (threadIdx.x == 0) {
        unsigned* bar = b.bar;
        __builtin_amdgcn_s_waitcnt(0);
        unsigned nloc = b.st[0], nx = b.st[1];
        if (nloc == 0u) { xcd_barrier_complete(bar, b.x, nloc, nx); b.st[0] = nloc; b.st[1] = nx; }
        const unsigned old = xb_add(&bar[XB_XSUB(b.x)], 1u);
        const unsigned gen = old / nloc;
        if (old + 1u == (gen + 1u) * nloc) {
            __builtin_amdgcn_fence(__ATOMIC_RELEASE, "agent");
            asm volatile("s_waitcnt vmcnt(0)" ::: "memory");
            const unsigned og = xb_add(&bar[XB_TOP], 1u);
            const unsigned tg = og / nx;
            if (og + 1u == (tg + 1u) * nx) xb_add(&bar[XB_TOPGEN], 1u);
            else XB_SPIN(xb_ld(&bar[XB_TOPGEN]) == tg, bar);
            __builtin_amdgcn_fence(__ATOMIC_ACQUIRE, "agent");
            xb_add(&bar[XB_XGEN(b.x)], 1u);
            asm volatile("s_waitcnt vmcnt(0)" ::: "memory");
        } else {
            XB_SPIN(xb_ld(&bar[XB_XGEN(b.x)]) == gen, bar);
            __builtin_amdgcn_fence(__ATOMIC_ACQUIRE, "agent");
            asm volatile("s_waitcnt vmcnt(0)" ::: "memory");
        }
    }
    __syncthreads();
}

constexpr int T = 18432, TP = 16384, DM = 1024;
constexpr float DN_ALPHA = 1.41421356237f;
constexpr float LN_EPS = 1e-5f;
constexpr size_t O_YP = 0, O_YS = 16777216, O_SSMP = 18874368, O_CONVP = 20971520, O_SSMS = 21069824, O_CONVS = 29458432, O_VROWS = 29851648;
constexpr size_t WS_XB = 0, WS_BIG = 37748736, WS_WOUT = 188743680, WS_W1 = 192937984, WS_W2 = 209715200, WS_CMWIN = 226492416, WS_CMWOUT = 234881024, WS_BAR = 239075328, WS_WIN = 239091712, WS_DT = 251740160, WS_END = 254099456, WS_BND = 256000000, WS_VST = 263077888;
constexpr size_t WS_SLAB = WS_WIN, WS_NEED = WS_VST + 147456;
constexpr int LDS_BYTES = 149504, LDS_BARST = 149472;
constexpr int NPHASE = 17;

struct Params { const float* in[25]; float* out; unsigned char* ws; int ph_lo, ph_hi; };

__device__ __forceinline__ float bf_lo(unsigned w) { return __uint_as_float(w << 16); }
__device__ __forceinline__ float bf_hi(unsigned w) { return __uint_as_float(w & 0xffff0000u); }
__device__ __forceinline__ unsigned short f2bf(float f) { unsigned u = __float_as_uint(f); u += 0x7FFFu + ((u >> 16) & 1u); return (unsigned short)(u >> 16); }
__device__ __forceinline__ float silu_f(float x) { return x * __builtin_amdgcn_rcpf(1.0f + __expf(-x)); }
__device__ __forceinline__ float wave_sum(float v) {
#pragma unroll
    for (int o = 32; o >= 1; o >>= 1) v += __shfl_xor(v, o);
    return v;
}
__device__ __forceinline__ f32x4 mfma16(bf16x8 a, bf16x8 b, f32x4 c) { return __builtin_amdgcn_mfma_f32_16x16x32_bf16(a, b, c, 0, 0, 0); }

__device__ __forceinline__ void transpose_cvt(const float* __restrict__ W, int K, int N, bf16_t* __restrict__ WT, ldsp lds) {
    LAS float* tile = (LAS float*)lds;
    const int tid = threadIdx.x; const int ntn = (N + 63) / 64, ntiles = (K / 64) * ntn;
    for (int t = blockIdx.x; t < ntiles; t += gridDim.x) {
        const int k0 = (t / ntn) * 64, n0 = (t % ntn) * 64;
#pragma unroll
        for (int i = 0; i < 8; ++i) { const int k = (tid >> 6) + 8 * i, n = tid & 63; tile[k * 65 + n] = (n0 + n < N) ? W[(size_t)(k0 + k) * N + n0 + n] : 0.f; }
        __syncthreads();
#pragma unroll
        for (int i = 0; i < 4; ++i) { const int kp = 2 * (tid & 31), nn = (tid >> 5) + 16 * i;
            if (n0 + nn < N) *(unsigned*)(WT + (size_t)(n0 + nn) * K + k0 + kp) = cvt_pk_bf16(tile[kp * 65 + nn], tile[(kp + 1) * 65 + nn]); }
        __syncthreads();
    }
}
__device__ __forceinline__ void phase_prep(const Params& p, ldsp lds) {
    unsigned char* ws = p.ws;
    transpose_cvt(p.in[4], 1024, 6176, (bf16_t*)(ws + WS_WIN), lds);
    transpose_cvt(p.in[11], 2048, 1024, (bf16_t*)(ws + WS_WOUT), lds);
    transpose_cvt(p.in[19], 1024, 4096, (bf16_t*)(ws + WS_W1), lds);
    transpose_cvt(p.in[19] + (size_t)1024 * 4096, 1024, 4096, (bf16_t*)(ws + WS_W1) + (size_t)4096 * 1024, lds);
    transpose_cvt(p.in[20], 4096, 1024, (bf16_t*)(ws + WS_W2), lds);
    transpose_cvt(p.in[20] + (size_t)4096 * 1024, 4096, 1024, (bf16_t*)(ws + WS_W2) + (size_t)4096 * 1024, lds);
    transpose_cvt(p.in[12], 1024, 4096, (bf16_t*)(ws + WS_CMWIN), lds);
    transpose_cvt(p.in[18], 2048, 1024, (bf16_t*)(ws + WS_CMWOUT), lds);
    const f32x4* xp = (const f32x4*)p.in[0]; const f32x4* xs = (const f32x4*)p.in[1]; u32x2* xb = (u32x2*)(ws + WS_XB);
    const int n4p = TP * DM / 4, n4 = T * DM / 4;
    for (int i = blockIdx.x * 512 + threadIdx.x; i < n4; i += gridDim.x * 512) { const f32x4 v = (i < n4p) ? xp[i] : xs[i - n4p]; u32x2 w; w.x = cvt_pk_bf16(v[0], v[1]); w.y = cvt_pk_bf16(v[2], v[3]); xb[i] = w; }
}

__device__ __forceinline__ void phase_dt(const Params& p) {
    const int tid = threadIdx.x, wid = tid >> 6, lane = tid & 63;
    const bf16_t* XB = (const bf16_t*)(p.ws + WS_XB); const bf16_t* WT = (const bf16_t*)(p.ws + WS_WIN) + (size_t)6144 * 1024; float* DT = (float*)(p.ws + WS_DT);
    const float* bias = p.in[7];
    for (int tile = blockIdx.x * 8 + wid; tile < T / 16; tile += gridDim.x * 8) {
        f32x4 a0 = {0.f, 0.f, 0.f, 0.f}, a1 = {0.f, 0.f, 0.f, 0.f};
        const bf16_t* ap = XB + (size_t)(tile * 16 + (lane & 15)) * 1024 + 8 * (lane >> 4);
        const bf16_t* bp0 = WT + (size_t)(lane & 15) * 1024 + 8 * (lane >> 4); const bf16_t* bp1 = bp0 + 16 * 1024;
#pragma unroll 4
        for (int kk = 0; kk < 32; ++kk) { const bf16x8 a = *(const bf16x8*)(ap + kk * 32), b0 = *(const bf16x8*)(bp0 + kk * 32), b1 = *(const bf16x8*)(bp1 + kk * 32); a0 = mfma16(a, b0, a0); a1 = mfma16(a, b1, a1); }
        const int hd = lane & 15; const float bb0 = bias[hd], bb1 = bias[16 + hd];
#pragma unroll
        for (int r = 0; r < 4; ++r) { const int tok = tile * 16 + (lane >> 4) * 4 + r; const float x0 = a0[r] + bb0, x1 = a1[r] + bb1;
            DT[(size_t)tok * 32 + hd] = x0 > 20.f ? x0 : log1pf(__expf(x0)); DT[(size_t)tok * 32 + 16 + hd] = x1 > 20.f ? x1 : log1pf(__expf(x1)); }
    }
}

__device__ __forceinline__ void phase_conv(const Params& p, const XcdBarrier& bar) {
    const int wid = threadIdx.x >> 6, lane = threadIdx.x & 63;
    bf16_t* XBC = (bf16_t*)(p.ws + WS_BIG);
    const bf16_t* BND = (const bf16_t*)(p.ws + WS_BND);
#pragma unroll
    for (int uu = 0; uu < 2; ++uu) { const int unit = blockIdx.x * 8 + wid + uu * (int)gridDim.x * 8; if (unit >= 2304) break;
        const int c = unit >> 3, ch = (unit & 7) * 512 + lane * 8;
        float cw[4][8], cb[8];
#pragma unroll
        for (int k = 0; k < 4; ++k) { const f32x4 a0 = *(const f32x4*)(p.in[5] + k * 4096 + ch), a1 = *(const f32x4*)(p.in[5] + k * 4096 + ch + 4);
#pragma unroll
            for (int e = 0; e < 4; ++e) { cw[k][e] = a0[e]; cw[k][4 + e] = a1[e]; } }
        { const f32x4 a0 = *(const f32x4*)(p.in[6] + ch), a1 = *(const f32x4*)(p.in[6] + ch + 4);
#pragma unroll
            for (int e = 0; e < 4; ++e) { cb[e] = a0[e]; cb[4 + e] = a1[e]; } }
        float xm[3][8];
        const bool seq_last = c >= 256 || (c & 31) == 31;
        if (c >= 256) { const float* cp = p.in[3] + (size_t)(c - 256) * 3 * 4096 + ch;
#pragma unroll
            for (int k = 0; k < 3; ++k) { const f32x4 a0 = *(const f32x4*)(cp + k * 4096), a1 = *(const f32x4*)(cp + k * 4096 + 4);
#pragma unroll
                for (int e = 0; e < 4; ++e) { xm[k][e] = a0[e]; xm[k][4 + e] = a1[e]; } } }
        else {
#pragma unroll
            for (int k = 0; k < 3; ++k) { const u32x4 r = (c & 31) != 0 ? *(const u32x4*)(BND + (size_t)((c - 1) * 3 + k) * 4096 + ch) : (u32x4){0u, 0u, 0u, 0u};
                xm[k][0] = bf_lo(r.x); xm[k][1] = bf_hi(r.x); xm[k][2] = bf_lo(r.y); xm[k][3] = bf_hi(r.y); xm[k][4] = bf_lo(r.z); xm[k][5] = bf_hi(r.z); xm[k][6] = bf_lo(r.w); xm[k][7] = bf_hi(r.w); } }
        float* cdst = (c >= 256 ? p.out + O_CONVS + (size_t)(c - 256) * 3 * 4096 : p.out + O_CONVP + (size_t)(c >> 5) * 3 * 4096) + ch;
        bf16_t* base = XBC + (size_t)(64 * c) * 4096 + ch;
        for (int t0 = 0; t0 < 64; t0 += 8) {
            u32x4 r[8];
#pragma unroll
            for (int i = 0; i < 8; ++i) r[i] = *(const u32x4*)(base + (size_t)(t0 + i) * 4096);
#pragma unroll
            for (int i = 0; i < 8; ++i) {
                const float x0[8] = {bf_lo(r[i].x), bf_hi(r[i].x), bf_lo(r[i].y), bf_hi(r[i].y), bf_lo(r[i].z), bf_hi(r[i].z), bf_lo(r[i].w), bf_hi(r[i].w)};
                float o[8];
#pragma unroll
                for (int e = 0; e < 8; ++e) o[e] = silu_f(cb[e] + cw[0][e] * xm[0][e] + cw[1][e] * xm[1][e] + cw[2][e] * xm[2][e] + cw[3][e] * x0[e]);
                u32x4 w; w.x = cvt_pk_bf16(o[0], o[1]); w.y = cvt_pk_bf16(o[2], o[3]); w.z = cvt_pk_bf16(o[4], o[5]); w.w = cvt_pk_bf16(o[6], o[7]);
                *(u32x4*)(base + (size_t)(t0 + i) * 4096) = w;
                if (seq_last && t0 == 56 && i >= 5) { float* d = cdst + (i - 5) * 4096; *(f32x4*)d = (f32x4){x0[0], x0[1], x0[2], x0[3]}; *(f32x4*)(d + 4) = (f32x4){x0[4], x0[5], x0[6], x0[7]}; }
#pragma unroll
                for (int e = 0; e < 8; ++e) { xm[0][e] = xm[1][e]; xm[1][e] = xm[2][e]; xm[2][e] = x0[e]; } }
        }
    }
}

constexpr int N_CS = 0, N_BS = 17408, N_BT = 34816, N_XDT = 53248, N_XW = 62464, N_XS = 71680, N_HB = 80896, N_WP = 98304, N_DTS = 116736, N_ACS = 116992, N_CW = 117248;
constexpr int ST128 = 272, ST64 = 144;
__device__ __forceinline__ int scan_chan(int j0, int h, int g) { return j0 < 64 ? h * 64 + j0 : (j0 < 192 ? 2048 + g * 128 + (j0 - 64) : 3072 + g * 128 + (j0 - 192)); }
__device__ __forceinline__ int tsw(int row, int slot) { return row * ST64 + ((slot ^ ((row >> 3) & 7)) << 4); }
__device__ __forceinline__ unsigned pk_lolo(unsigned a, unsigned b) { return (a & 0xffffu) | (b << 16); }
__device__ __forceinline__ unsigned pk_hihi(unsigned a, unsigned b) { return (a >> 16) | (b & 0xffff0000u); }
__device__ __forceinline__ float rdlane(float v, int l) { return __int_as_float(__builtin_amdgcn_readlane(__float_as_int(v), l)); }
template <bool DUMMY> __device__ __forceinline__ void phase_scan(const Params& p, ldsp lds) {
    const int tid = threadIdx.x, wid = __builtin_amdgcn_readfirstlane(tid >> 6), lane0 = tid & 63, lane = lane0, fr = lane & 15, fq = lane >> 4;
    const int ti = wid >> 1, half = wid & 1, hp = ti;
    const bool cl = lane < 40;
    const bf16_t* XBC = (const bf16_t*)(p.ws + WS_BIG); bf16_t* Z = (bf16_t*)p.out; const float* DT = (const float*)(p.ws + WS_DT);
    LAS float* dts = (LAS float*)(lds + N_DTS); LAS float* acs = (LAS float*)(lds + N_ACS);
    ldsp wp = lds + N_WP + wid * 2304;
    for (int chain = blockIdx.x; chain < 1280; chain += gridDim.x) {
        int b, h, nsteps, row0; const float* h0 = nullptr; const float* cprev = nullptr; float* hout; float* cdst;
        if (chain < 256) { b = chain >> 5; h = (chain & 7) * 4 + ((chain >> 3) & 3); nsteps = 32; row0 = b * 2048; hout = p.out + O_SSMP + (size_t)(b * 32 + h) * 8192; cdst = p.out + O_CONVP + (size_t)b * 3 * 4096; }
        else { const int i = chain - 256; b = i >> 5; h = (i & 7) * 4 + ((i >> 3) & 3); nsteps = 1; row0 = TP + b * 64; h0 = p.in[2] + (size_t)(b * 32 + h) * 8192; cprev = p.in[3] + (size_t)b * 3 * 4096; hout = p.out + O_SSMS + (size_t)(b * 32 + h) * 8192; cdst = p.out + O_CONVS + (size_t)b * 3 * 4096; }
        const int g = h >> 2; const float A_h = -__expf(p.in[8][h]), D_h = p.in[9][h];
        const int ch0 = scan_chan(cl ? 8 * lane : 0, h, g);
        f32x4 hacc[4];
#pragma unroll
        for (int q = 0; q < 4; ++q)
#pragma unroll
            for (int r = 0; r < 4; ++r) { const int pp = hp * 16 + 4 * fq + r, n = (4 * half + q) * 16 + fr; const float v = h0 ? h0[pp * 128 + n] : 0.f; hacc[q][r] = v;
                *(LAS unsigned short*)(lds + N_HB + pp * ST128 + n * 2) = f2bf(v); }
        u32x4 raw[11]; u32x4 zr; float dtv;
#define SCAN_PREFETCH(s_) do { const int Rn_ = row0 + 64 * (s_); \
            if (cl) { _Pragma("unroll") for (int i = 0; i < 8; ++i) raw[3 + i] = *(const u32x4*)(XBC + (size_t)(Rn_ + 8 * wid + i) * 4096 + ch0); } \
            zr = *(const u32x4*)(Z + (size_t)(Rn_ + 16 * ti + (lane >> 2)) * 2048 + h * 64 + 32 * half + (lane & 3) * 8); \
            dtv = DT[(size_t)(Rn_ + lane) * 32 + h]; } while (0)
#pragma unroll
        for (int i = 0; i < 11; ++i) raw[i] = (u32x4){0u, 0u, 0u, 0u};
        SCAN_PREFETCH(0);
        for (int step = 0; step < nsteps; ++step) {
            const int R = row0 + step * 64;
            int lane_o = lane0; asm volatile("" : "+v"(lane_o));
            const int lane = lane_o, fr = lane & 15, fq = lane >> 4;
            float ac = dtv * A_h;
#pragma unroll
            for (int d = 1; d < 64; d <<= 1) { const float n = __shfl_up(ac, d); if (lane >= d) ac += n; }
            dts[lane] = dtv; acs[lane] = ac;
            const float a_last = rdlane(ac, 63);
            if (false) {
#pragma unroll
                for (int k = 0; k < 3; ++k) { const u32x4 r = raw[8 + k]; float* d = cdst + k * 4096 + ch0;
                    *(f32x4*)d = (f32x4){bf_lo(r.x), bf_hi(r.x), bf_lo(r.y), bf_hi(r.y)}; *(f32x4*)(d + 4) = (f32x4){bf_lo(r.z), bf_hi(r.z), bf_lo(r.w), bf_hi(r.w)}; } }
            if (cl) {
                float s1[8], s2[8];
#pragma unroll
                for (int j = 0; j < 8; ++j) { const float dtt = rdlane(dtv, 8 * wid + j), act = rdlane(ac, 8 * wid + j); s1[j] = dtt; s2[j] = dtt * __expf(a_last - act); }
                const int rmbase = lane < 8 ? N_XS + lane * 16 : (lane < 24 ? N_BS + (lane - 8) * 16 : N_CS + (lane - 24) * 16); const int rmst = lane < 8 ? ST64 : ST128;
#pragma unroll
                for (int j = 0; j < 8; ++j) *(LAS u32x4*)(lds + rmbase + (8 * wid + j) * rmst) = raw[3 + j];
                if (lane < 8) {
#pragma unroll
                    for (int e = 0; e < 8; ++e) { float vv[8];
#pragma unroll
                        for (int j = 0; j < 8; ++j) { const unsigned w = e < 2 ? raw[3 + j].x : e < 4 ? raw[3 + j].y : e < 6 ? raw[3 + j].z : raw[3 + j].w; vv[j] = (e & 1) ? bf_hi(w) : bf_lo(w); }
                        u32x4 v; v.x = cvt_pk_bf16(vv[0] * s1[0], vv[1] * s1[1]); v.y = cvt_pk_bf16(vv[2] * s1[2], vv[3] * s1[3]); v.z = cvt_pk_bf16(vv[4] * s1[4], vv[5] * s1[5]); v.w = cvt_pk_bf16(vv[6] * s1[6], vv[7] * s1[7]);
                        *(LAS u32x4*)(lds + N_XDT + tsw(8 * lane + e, wid)) = v;
                        v.x = cvt_pk_bf16(vv[0] * s2[0], vv[1] * s2[1]); v.y = cvt_pk_bf16(vv[2] * s2[2], vv[3] * s2[3]); v.z = cvt_pk_bf16(vv[4] * s2[4], vv[5] * s2[5]); v.w = cvt_pk_bf16(vv[6] * s2[6], vv[7] * s2[7]);
                        *(LAS u32x4*)(lds + N_XW + tsw(8 * lane + e, wid)) = v; } }
                else if (lane < 24) {
#pragma unroll
                    for (int e = 0; e < 8; ++e) { u32x4 v;
                        const unsigned w0 = e < 2 ? raw[3].x : e < 4 ? raw[3].y : e < 6 ? raw[3].z : raw[3].w, w1 = e < 2 ? raw[4].x : e < 4 ? raw[4].y : e < 6 ? raw[4].z : raw[4].w;
                        const unsigned w2 = e < 2 ? raw[5].x : e < 4 ? raw[5].y : e < 6 ? raw[5].z : raw[5].w, w3 = e < 2 ? raw[6].x : e < 4 ? raw[6].y : e < 6 ? raw[6].z : raw[6].w;
                        const unsigned w4 = e < 2 ? raw[7].x : e < 4 ? raw[7].y : e < 6 ? raw[7].z : raw[7].w, w5 = e < 2 ? raw[8].x : e < 4 ? raw[8].y : e < 6 ? raw[8].z : raw[8].w;
                        const unsigned w6 = e < 2 ? raw[9].x : e < 4 ? raw[9].y : e < 6 ? raw[9].z : raw[9].w, w7 = e < 2 ? raw[10].x : e < 4 ? raw[10].y : e < 6 ? raw[10].z : raw[10].w;
                        if (e & 1) { v.x = pk_hihi(w0, w1); v.y = pk_hihi(w2, w3); v.z = pk_hihi(w4, w5); v.w = pk_hihi(w6, w7); }
                        else       { v.x = pk_lolo(w0, w1); v.y = pk_lolo(w2, w3); v.z = pk_lolo(w4, w5); v.w = pk_lolo(w6, w7); }
                        *(LAS u32x4*)(lds + N_BT + tsw(8 * (lane - 8) + e, wid)) = v; } }
            }
            const u32x4 zcur = zr;
            asm volatile("" ::: "memory"); __builtin_amdgcn_sched_barrier(0);
            if (step + 1 < nsteps) SCAN_PREFETCH(step + 1);
            asm volatile("" ::: "memory"); __builtin_amdgcn_sched_barrier(0);
            __syncthreads();
            f32x4 yacc[2];
            { bf16x8 af[4];
#pragma unroll
                for (int kk = 0; kk < 4; ++kk) af[kk] = *(const LAS bf16x8*)(lds + N_CS + (ti * 16 + fr) * ST128 + (kk * 32 + 8 * fq) * 2);
                float act[4];
#pragma unroll
                for (int r = 0; r < 4; ++r) act[r] = acs[ti * 16 + 4 * fq + r];
#pragma unroll
                for (int si = 0; si < 4; ++si) {
                    if (si <= ti) { f32x4 cb = {0.f, 0.f, 0.f, 0.f};
#pragma unroll
                        for (int kk = 0; kk < 4; ++kk) cb = mfma16(af[kk], *(const LAS bf16x8*)(lds + N_BS + (si * 16 + fr) * ST128 + (kk * 32 + 8 * fq) * 2), cb);
                        const int s = si * 16 + fr; const float as = acs[s];
#pragma unroll
                        for (int r = 0; r < 4; ++r) { const int t = ti * 16 + 4 * fq + r; const float mv = (s <= t) ? cb[r] * __expf(act[r] - as) : 0.f; *(LAS unsigned short*)(wp + (4 * fq + r) * ST64 + s * 2) = f2bf(mv); } }
                    else if (si == (ti | 1)) {
#pragma unroll
                        for (int r = 0; r < 4; ++r) *(LAS unsigned short*)(wp + (4 * fq + r) * ST64 + (si * 16 + fr) * 2) = (unsigned short)0; } }
#pragma unroll
                for (int q = 0; q < 2; ++q) { const int pi = 2 * half + q; f32x4 y = {0.f, 0.f, 0.f, 0.f};
#pragma unroll
                    for (int kk = 0; kk < 4; ++kk) y = mfma16(af[kk], *(const LAS bf16x8*)(lds + N_HB + (pi * 16 + fr) * ST128 + (kk * 32 + 8 * fq) * 2), y);
#pragma unroll
                    for (int r = 0; r < 4; ++r) y[r] *= __expf(act[r]);
                    yacc[q] = y; } }
            __syncthreads();
            {
#pragma unroll
                for (int q = 0; q < 2; ++q) { const int pi = 2 * half + q;
#pragma unroll
                    for (int kk = 0; kk < 2; ++kk) if (2 * kk <= ti) yacc[q] = mfma16(*(const LAS bf16x8*)(wp + fr * ST64 + (kk * 32 + 8 * fq) * 2), *(const LAS bf16x8*)(lds + N_XDT + tsw(pi * 16 + fr, 4 * kk + fq)), yacc[q]); }
                const float ea = __expf(a_last);
                bf16x8 xa[2];
#pragma unroll
                for (int kk = 0; kk < 2; ++kk) xa[kk] = *(const LAS bf16x8*)(lds + N_XW + tsw(hp * 16 + fr, 4 * kk + fq));
#pragma unroll
                for (int q = 0; q < 4; ++q) { const int ni = 4 * half + q; f32x4 hv = hacc[q] * ea;
#pragma unroll
                    for (int kk = 0; kk < 2; ++kk) hv = mfma16(xa[kk], *(const LAS bf16x8*)(lds + N_BT + tsw(ni * 16 + fr, 4 * kk + fq)), hv);
                    hacc[q] = hv;
#pragma unroll
                    for (int r = 0; r < 4; ++r) *(LAS unsigned short*)(lds + N_HB + (hp * 16 + 4 * fq + r) * ST128 + (ni * 16 + fr) * 2) = f2bf(hv[r]); }
                __builtin_amdgcn_wave_barrier();
#pragma unroll
                for (int q = 0; q < 2; ++q)
#pragma unroll
                    for (int r = 0; r < 4; ++r) *(LAS float*)(wp + (4 * fq + r) * 144 + (16 * q + fr) * 4) = yacc[q][r];
                __builtin_amdgcn_wave_barrier();
                const int tl = lane >> 2, pq = lane & 3;
                const f32x4 y0 = *(const LAS f32x4*)(wp + tl * 144 + pq * 32), y1 = *(const LAS f32x4*)(wp + tl * 144 + pq * 32 + 16);
                const u32x4 xr = *(const LAS u32x4*)(lds + N_XS + (16 * ti + tl) * ST64 + (32 * half + 8 * pq) * 2);
                const float xs[8] = {bf_lo(xr.x), bf_hi(xr.x), bf_lo(xr.y), bf_hi(xr.y), bf_lo(xr.z), bf_hi(xr.z), bf_lo(xr.w), bf_hi(xr.w)};
                const float zz[8] = {bf_lo(zcur.x), bf_hi(zcur.x), bf_lo(zcur.y), bf_hi(zcur.y), bf_lo(zcur.z), bf_hi(zcur.z), bf_lo(zcur.w), bf_hi(zcur.w)};
                float gg[8];
#pragma unroll
                for (int e = 0; e < 8; ++e) { const float yv = (e < 4 ? y0[e & 3] : y1[e & 3]) + D_h * xs[e]; gg[e] = yv * silu_f(zz[e]); }
                u32x4 w; w.x = cvt_pk_bf16(gg[0], gg[1]); w.y = cvt_pk_bf16(gg[2], gg[3]); w.z = cvt_pk_bf16(gg[4], gg[5]); w.w = cvt_pk_bf16(gg[6], gg[7]);
                if (DUMMY) *(u32x4*)((bf16_t*)(p.ws + WS_END) + (size_t)(blockIdx.x * 64 + 16 * ti + tl) * 64 + 32 * half + 8 * pq) = w;
                else *(u32x4*)(Z + (size_t)(R + 16 * ti + tl) * 2048 + h * 64 + 32 * half + 8 * pq) = w; }
            __syncthreads();
        }
#undef SCAN_PREFETCH
#pragma unroll
        for (int q = 0; q < 4; ++q)
#pragma unroll
            for (int r = 0; r < 4; ++r) hout[(hp * 16 + 4 * fq + r) * 128 + (4 * half + q) * 16 + fr] = hacc[q][r];
    }
}

__device__ __forceinline__ void phase_gnorm(const Params& p) {
    const int wid = threadIdx.x >> 6, lane = threadIdx.x & 63; bf16_t* Z = (bf16_t*)p.out; const float* nw = p.in[10];
    for (int row = blockIdx.x * 8 + wid; row < T; row += gridDim.x * 8) {
        bf16_t* zr = Z + (size_t)row * 2048 + 8 * lane;
        u32x4 raw[4];
#pragma unroll
        for (int j = 0; j < 4; ++j) raw[j] = *(const u32x4*)(zr + 512 * j);
#pragma unroll
        for (int j = 0; j < 4; ++j) { const float v[8] = {bf_lo(raw[j].x), bf_hi(raw[j].x), bf_lo(raw[j].y), bf_hi(raw[j].y), bf_lo(raw[j].z), bf_hi(raw[j].z), bf_lo(raw[j].w), bf_hi(raw[j].w)};
            float ss = 0.f;
#pragma unroll
            for (int e = 0; e < 8; ++e) ss += v[e] * v[e];
#pragma unroll
            for (int o = 16; o >= 1; o >>= 1) ss += __shfl_xor(ss, o);
            const float sc = rsqrtf(ss * (1.0f / 256.0f) + LN_EPS);
            const f32x4 w0 = *(const f32x4*)(nw + 512 * j + 8 * lane), w1 = *(const f32x4*)(nw + 512 * j + 8 * lane + 4);
            u32x4 w; w.x = cvt_pk_bf16(v[0] * sc * w0[0], v[1] * sc * w0[1]); w.y = cvt_pk_bf16(v[2] * sc * w0[2], v[3] * sc * w0[3]); w.z = cvt_pk_bf16(v[4] * sc * w1[0], v[5] * sc * w1[1]); w.w = cvt_pk_bf16(v[6] * sc * w1[2], v[7] * sc * w1[3]);
            *(u32x4*)(zr + 512 * j) = w; }
    }
}

__device__ __forceinline__ void phase_ln(const float* src, const float* resS, const bf16_t* slabs, float* dstf, bf16_t* dstb, const float* gam, const float* bet) {
    const int wid = threadIdx.x >> 6, lane = threadIdx.x & 63;
    f32x4 gv[4], bv[4];
#pragma unroll
    for (int j = 0; j < 4; ++j) { gv[j] = *(const f32x4*)(gam + 256 * j + 4 * lane); bv[j] = *(const f32x4*)(bet + 256 * j + 4 * lane); }
    for (int row = blockIdx.x * 8 + wid; row < T; row += gridDim.x * 8) {
        f32x4 v[4]; float sum = 0.f;
        if (row < TP) { const float* sp = src + (size_t)row * 1024 + 4 * lane;
#pragma unroll
            for (int j = 0; j < 4; ++j) v[j] = *(const f32x4*)(sp + 256 * j); }
        else { const int r = row - TP; const float* rp = resS + (size_t)r * 1024 + 4 * lane; const bf16_t* sl = slabs + (size_t)((r >> 8) * 16) * 65536 + (r & 255) * 256 + 4 * lane;
#pragma unroll
            for (int j = 0; j < 4; ++j) { f32x4 a = *(const f32x4*)(rp + 256 * j) * DN_ALPHA;
#pragma unroll
                for (int k = 0; k < 4; ++k) { const u32x2 w = *(const u32x2*)(sl + (size_t)(j * 4 + k) * 65536); a += (f32x4){bf_lo(w.x), bf_hi(w.x), bf_lo(w.y), bf_hi(w.y)}; }
                v[j] = a; } }
#pragma unroll
        for (int j = 0; j < 4; ++j) sum += (v[j][0] + v[j][1]) + (v[j][2] + v[j][3]);
        const float mean = wave_sum(sum) * (1.0f / 1024.0f); float q = 0.f;
#pragma unroll
        for (int j = 0; j < 4; ++j) { const f32x4 d = v[j] - mean; q += (d[0] * d[0] + d[1] * d[1]) + (d[2] * d[2] + d[3] * d[3]); }
        const float rstd = rsqrtf(wave_sum(q) * (1.0f / 1024.0f) + LN_EPS);
#pragma unroll
        for (int j = 0; j < 4; ++j) { const f32x4 o = (v[j] - mean) * rstd * gv[j] + bv[j];
            *(f32x4*)(dstf + (size_t)row * 1024 + 4 * lane + 256 * j) = o;
            if (dstb) { u32x2 w; w.x = cvt_pk_bf16(o[0], o[1]); w.y = cvt_pk_bf16(o[2], o[3]); *(u32x2*)(dstb + (size_t)row * 1024 + 4 * lane + 256 * j) = w; } }
    }
}

__device__ __forceinline__ void phase_lnv(const Params& p) {
    const int wid = threadIdx.x >> 6, lane = threadIdx.x & 63; bf16_t* BIG = (bf16_t*)(p.ws + WS_BIG); const float* gam = p.in[14]; const float* bet = p.in[15]; float* vrows = p.out + O_VROWS;
    for (int row = blockIdx.x * 8 + wid; row < T; row += gridDim.x * 8) {
        bf16_t* vr = BIG + (size_t)row * 4096 + 2048 + 8 * lane; float v[4][8]; float sum = 0.f;
#pragma unroll
        for (int j = 0; j < 4; ++j) { const u32x4 r = *(const u32x4*)(vr + 512 * j);
            v[j][0] = bf_lo(r.x); v[j][1] = bf_hi(r.x); v[j][2] = bf_lo(r.y); v[j][3] = bf_hi(r.y); v[j][4] = bf_lo(r.z); v[j][5] = bf_hi(r.z); v[j][6] = bf_lo(r.w); v[j][7] = bf_hi(r.w);
#pragma unroll
            for (int e = 0; e < 8; ++e) sum += v[j][e]; }
        const float mean = wave_sum(sum) * (1.0f / 2048.0f); float q = 0.f;
#pragma unroll
        for (int j = 0; j < 4; ++j)
#pragma unroll
            for (int e = 0; e < 8; ++e) { const float d = v[j][e] - mean; q += d * d; }
        const float rstd = rsqrtf(wave_sum(q) * (1.0f / 2048.0f) + LN_EPS);
#pragma unroll
        for (int j = 0; j < 4; ++j) { const int c = 512 * j + 8 * lane;
            const f32x4 g0 = *(const f32x4*)(gam + c), g1 = *(const f32x4*)(gam + c + 4), b0 = *(const f32x4*)(bet + c), b1 = *(const f32x4*)(bet + c + 4);
            f32x4 o0, o1;
#pragma unroll
            for (int e = 0; e < 4; ++e) { o0[e] = (v[j][e] - mean) * rstd * g0[e] + b0[e]; o1[e] = (v[j][4 + e] - mean) * rstd * g1[e] + b1[e]; }
            u32x4 w; w.x = cvt_pk_bf16(o0[0], o0[1]); w.y = cvt_pk_bf16(o0[2], o0[3]); w.z = cvt_pk_bf16(o1[0], o1[1]); w.w = cvt_pk_bf16(o1[2], o1[3]);
            *(u32x4*)(vr + 512 * j) = w;
            if (row >= TP) { float* d = vrows + (size_t)(row - TP) * 2048 + c; *(f32x4*)d = o0; *(f32x4*)(d + 4) = o1; } }
    }
}

constexpr int SP_VT = 0, SP_WS = 69632, SP_SO = 0, SP_VST = 272, SP_SOST = 528;
__device__ __forceinline__ int vtsw(int c, int slot) { return c * SP_VST + ((slot ^ ((c >> 3) & 7)) << 4); }
template <bool DUMMY> __device__ __forceinline__ void phase_spatial(const Params& p, ldsp lds) {
    const int tid = threadIdx.x, wid = tid >> 6, lane = tid & 63, fr = lane & 15, fq = lane >> 4;
    bf16_t* BIG = (bf16_t*)(p.ws + WS_BIG); const float* wsp = p.in[16]; const float* bsp = p.in[17]; const float* vst = (const float*)(p.ws + WS_VST); float* vrows = p.out + O_VROWS;
    for (int unit = blockIdx.x; unit < 1280; unit += gridDim.x) {
        int R, L, g;
        if (unit < 1024) { g = unit & 7; R = (unit >> 3) * 128; L = 128; } else { const int i = unit - 1024; g = i & 7; R = TP + (i >> 3) * 64; L = 64; }
        if (tid < L * 4) { const int c8 = (tid & 31) * 8, sb = tid >> 5; const int r0 = R + 8 * sb, cg = g * 256 + c8;
            u32x4 raw[8];
#pragma unroll
            for (int j = 0; j < 8; ++j) raw[j] = *(const u32x4*)(BIG + (size_t)(r0 + j) * 4096 + 2048 + cg);
            float mu[8], rs[8];
#pragma unroll
            for (int j4 = 0; j4 < 4; ++j4) { const f32x4 st = *(const f32x4*)(vst + (size_t)(r0 + 2 * j4) * 2);
                const float m0 = st[0] * (1.0f / 2048.0f), m1 = st[2] * (1.0f / 2048.0f);
                mu[2 * j4] = m0; rs[2 * j4] = rsqrtf(fmaxf(st[1] * (1.0f / 2048.0f) - m0 * m0, 0.f) + LN_EPS); mu[2 * j4 + 1] = m1; rs[2 * j4 + 1] = rsqrtf(fmaxf(st[3] * (1.0f / 2048.0f) - m1 * m1, 0.f) + LN_EPS); }
            const f32x4 g0 = *(const f32x4*)(p.in[14] + cg), g1 = *(const f32x4*)(p.in[14] + cg + 4), b0 = *(const f32x4*)(p.in[15] + cg), b1 = *(const f32x4*)(p.in[15] + cg + 4);
            const float gg[8] = {g0[0], g0[1], g0[2], g0[3], g1[0], g1[1], g1[2], g1[3]}, bb[8] = {b0[0], b0[1], b0[2], b0[3], b1[0], b1[1], b1[2], b1[3]};
            float vn[8][8];
#pragma unroll
            for (int j = 0; j < 8; ++j) { const float x[8] = {bf_lo(raw[j].x), bf_hi(raw[j].x), bf_lo(raw[j].y), bf_hi(raw[j].y), bf_lo(raw[j].z), bf_hi(raw[j].z), bf_lo(raw[j].w), bf_hi(raw[j].w)};
#pragma unroll
                for (int e = 0; e < 8; ++e) vn[j][e] = (x[e] - mu[j]) * rs[j] * gg[e] + bb[e];
                if (L == 64) { float* d = vrows + (size_t)(r0 + j - TP) * 2048 + cg; *(f32x4*)d = (f32x4){vn[j][0], vn[j][1], vn[j][2], vn[j][3]}; *(f32x4*)(d + 4) = (f32x4){vn[j][4], vn[j][5], vn[j][6], vn[j][7]}; } }
#pragma unroll
            for (int e = 0; e < 8; ++e) { u32x4 v; v.x = cvt_pk_bf16(vn[0][e], vn[1][e]); v.y = cvt_pk_bf16(vn[2][e], vn[3][e]); v.z = cvt_pk_bf16(vn[4][e], vn[5][e]); v.w = cvt_pk_bf16(vn[6][e], vn[7][e]);
                *(LAS u32x4*)(lds + SP_VT + vtsw(c8 + e, sb)) = v; } }
        for (int idx = tid; idx < L * (L / 4); idx += 512) { const int t = idx / (L / 4), s0 = (idx % (L / 4)) * 4; const f32x4 w = *(const f32x4*)(wsp + (size_t)(g * 128 + t) * 128 + s0);
            u32x2 o; o.x = cvt_pk_bf16(s0 <= t ? w[0] : 0.f, s0 + 1 <= t ? w[1] : 0.f); o.y = cvt_pk_bf16(s0 + 2 <= t ? w[2] : 0.f, s0 + 3 <= t ? w[3] : 0.f);
            *(LAS u32x2*)(lds + SP_WS + t * SP_VST + s0 * 2) = o; }
        __syncthreads();
        const int nT = L / 16, nK = L / 32;
        f32x4 acc[8][2];
#pragma unroll
        for (int ti = 0; ti < 8; ++ti) { acc[ti][0] = (f32x4){0.f, 0.f, 0.f, 0.f}; acc[ti][1] = (f32x4){0.f, 0.f, 0.f, 0.f}; }
#pragma unroll
        for (int kk = 0; kk < 4; ++kk) if (kk < nK) {
            const bf16x8 b0 = *(const LAS bf16x8*)(lds + SP_VT + vtsw(wid * 32 + fr, kk * 4 + fq)), b1 = *(const LAS bf16x8*)(lds + SP_VT + vtsw(wid * 32 + 16 + fr, kk * 4 + fq));
#pragma unroll
            for (int ti = 0; ti < 8; ++ti) if (ti < nT && 32 * kk <= 16 * ti + 15) { const bf16x8 a = *(const LAS bf16x8*)(lds + SP_WS + (ti * 16 + fr) * SP_VST + (kk * 32 + 8 * fq) * 2);
                acc[ti][0] = mfma16(a, b0, acc[ti][0]); acc[ti][1] = mfma16(a, b1, acc[ti][1]); } }
        __syncthreads();
#pragma unroll
        for (int ti = 0; ti < 8; ++ti) if (ti < nT) {
#pragma unroll
            for (int r = 0; r < 4; ++r) { const int t = ti * 16 + 4 * fq + r; const float bb = bsp[g * 128 + t];
                *(LAS unsigned short*)(lds + SP_SO + t * SP_SOST + (wid * 32 + fr) * 2) = f2bf(acc[ti][0][r] + bb); *(LAS unsigned short*)(lds + SP_SO + t * SP_SOST + (wid * 32 + 16 + fr) * 2) = f2bf(acc[ti][1][r] + bb); } }
        __syncthreads();
        for (int idx = tid; idx < L * 32; idx += 512) { const int t = idx >> 5, c8 = (idx & 31) * 8; bf16_t* up = BIG + (size_t)(R + t) * 4096 + g * 256 + c8;
            const u32x4 uu = *(const u32x4*)up; const u32x4 ss = *(const LAS u32x4*)(lds + SP_SO + t * SP_SOST + c8 * 2);
            u32x4 w; w.x = cvt_pk_bf16(bf_lo(uu.x) * bf_lo(ss.x), bf_hi(uu.x) * bf_hi(ss.x)); w.y = cvt_pk_bf16(bf_lo(uu.y) * bf_lo(ss.y), bf_hi(uu.y) * bf_hi(ss.y));
            w.z = cvt_pk_bf16(bf_lo(uu.z) * bf_lo(ss.z), bf_hi(uu.z) * bf_hi(ss.z)); w.w = cvt_pk_bf16(bf_lo(uu.w) * bf_lo(ss.w), bf_hi(uu.w) * bf_hi(ss.w));
            if (DUMMY) *(u32x4*)((bf16_t*)(p.ws + WS_END) + (size_t)blockIdx.x * 16384 + (t & 63) * 256 + c8) = w; else *(u32x4*)up = w; }
        __syncthreads();
    }
}

__global__ void __launch_bounds__(512, 2) fwd_kernel(Params p) {
    extern __shared__ __attribute__((aligned(16))) unsigned char smem[];
    ldsp lds = (ldsp)smem;
    cg::grid_group grid = cg::this_grid();
    if (threadIdx.x < 4) ((LAS unsigned*)(lds + LDS_BARST))[threadIdx.x] = 0u;
    __syncthreads();
    XcdBarrier bar; bar.bar = (unsigned*)(p.ws + WS_BAR); bar.x = 0; bar.st = (volatile LAS unsigned*)(lds + LDS_BARST);
    if (p.ph_hi > p.ph_lo) bar = xcd_barrier_post((unsigned*)(p.ws + WS_BAR), (volatile LAS unsigned*)(lds + LDS_BARST));
    unsigned char* ws = p.ws; const int G = gridDim.x, bid = blockIdx.x;
    bf16_t* XB = (bf16_t*)(ws + WS_XB); bf16_t* BIG = (bf16_t*)(ws + WS_BIG); float* Y = p.out; bf16_t* Zb = (bf16_t*)p.out; bf16_t* SLAB = (bf16_t*)(ws + WS_SLAB);
#ifndef REPMASK
#define REPMASK 0
#endif
#define RUN(k) (((PHMASK >> (k)) & 1) && p.ph_lo <= (k) && (k) <= p.ph_hi)
#define DO2(k, ...) do { if ((REPMASK >> (k)) & 1) { __VA_ARGS__ } __VA_ARGS__ } while (0)
#if USE_CG_SYNC
#define SEAM(k) do { if (p.ph_lo <= (k) && (k) < p.ph_hi) grid.sync(); } while (0)
#else
#define SEAM(k) do { if (p.ph_lo <= (k) && (k) < p.ph_hi) xcd_barrier(bar); } while (0)
#endif
    if (RUN(0)) DO2(0, { phase_prep(p, lds); });
    SEAM(0);
    if (RUN(1)) DO2(1, { pg8::Gemm g{XB, (const bf16_t*)(ws + WS_WIN), T, 6144, 1024, 1024}; pg8::StaticOrder S; S.init(T, 6144, G, bid, 1024);
        pg8::EpiG1 E{Zb, BIG, (bf16_t*)(ws + WS_BND)};
        pg8::gemm_phase<pg8::EpiG1, pg8::StaticOrder, true, true>(lds, g, S, E);
        phase_dt(p); });
    SEAM(1);
    if (RUN(1)) phase_conv(p, bar);
    if (p.ph_lo <= 1 && 1 <= p.ph_hi) { if (p.ph_hi > 1) xcd_barrier(bar); }
#ifdef PROBE_SCAN2
    if (RUN(2)) phase_scan<true>(p, lds);
#endif
    if (RUN(2)) phase_scan<false>(p, lds);
    SEAM(2);
    if (RUN(3)) phase_gnorm(p);
    SEAM(3);
    if (RUN(4)) DO2(4, { pg8::Gemm g{Zb, (const bf16_t*)(ws + WS_WOUT), T, 1024, 2048, 2048}; pg8::SplitOrder S; S.init(G, bid, 2048);
        pg8::EpiRes E{p.in[0], p.in[1], (float*)(ws + WS_BIG), DN_ALPHA, SLAB};
        pg8::gemm_phase<pg8::EpiRes, pg8::SplitOrder, true, true>(lds, g, S, E); });
    SEAM(4);
    if (RUN(5)) DO2(5, { phase_ln((const float*)(ws + WS_BIG), p.in[1], SLAB, Y, XB, p.in[21], p.in[22]); });
    SEAM(5);
    if (RUN(6)) DO2(6, { pg8::Gemm g{XB, (const bf16_t*)(ws + WS_W1), T, 4096, 1024, 1024}; pg8::StaticOrder S; S.init(T, 4096, G, bid, 1024);
        pg8::EpiAct<1> E{BIG, 4096, nullptr, nullptr};
        pg8::gemm_phase<pg8::EpiAct<1>, pg8::StaticOrder, true, true>(lds, g, S, E); });
    SEAM(6);
    if (RUN(7)) { pg8::Gemm g{BIG, (const bf16_t*)(ws + WS_W2), T, 1024, 4096, 4096}; pg8::SplitOrder S; S.init(G, bid, 4096);
        pg8::EpiRes E{Y, Y + (size_t)TP * 1024, Y, DN_ALPHA, SLAB};
        pg8::gemm_phase<pg8::EpiRes, pg8::SplitOrder, true, true>(lds, g, S, E); }
    SEAM(7);
    if (RUN(8)) phase_ln(Y, Y + (size_t)TP * 1024, SLAB, Y, XB, p.in[23], p.in[24]);
    SEAM(8);
    if (RUN(9)) DO2(9, { pg8::Gemm g{XB, (const bf16_t*)(ws + WS_CMWIN), T, 4096, 1024, 1024}; pg8::StaticOrder S; S.init(T, 4096, G, bid, 1024);
        pg8::EpiAct<2> E{BIG, 4096, p.in[13], (float*)(ws + WS_VST)};
        pg8::gemm_phase<pg8::EpiAct<2>, pg8::StaticOrder, true, true>(lds, g, S, E); });
    SEAM(9);
#ifdef PROBE_SPATIAL2
    if (RUN(11)) phase_spatial<true>(p, lds);
#endif
    if (RUN(11)) phase_spatial<false>(p, lds);
#ifdef PROBE_SYNC
    for (int i_ = 0; i_ < 16; ++i_) grid.sync();
#endif
    SEAM(11);
    if (RUN(12)) { pg8::Gemm g{BIG, (const bf16_t*)(ws + WS_CMWOUT), T, 1024, 2048, 4096}; pg8::SplitOrder S; S.init(G, bid, 2048);
        pg8::EpiRes E{Y, Y + (size_t)TP * 1024, Y, DN_ALPHA, SLAB};
        pg8::gemm_phase<pg8::EpiRes, pg8::SplitOrder, true, true>(lds, g, S, E); }
    SEAM(12);
    if (RUN(13)) phase_ln(Y, Y + (size_t)TP * 1024, SLAB, Y, XB, p.in[21] + 1024, p.in[22] + 1024);
    SEAM(13);
    if (RUN(14)) DO2(14, { pg8::Gemm g{XB, (const bf16_t*)(ws + WS_W1) + (size_t)4096 * 1024, T, 4096, 1024, 1024}; pg8::StaticOrder S; S.init(T, 4096, G, bid, 1024);
        pg8::EpiAct<1> E{BIG, 4096, nullptr, nullptr};
        pg8::gemm_phase<pg8::EpiAct<1>, pg8::StaticOrder, true, true>(lds, g, S, E); });
    SEAM(14);
    if (RUN(15)) { pg8::Gemm g{BIG, (const bf16_t*)(ws + WS_W2) + (size_t)4096 * 1024, T, 1024, 4096, 4096}; pg8::SplitOrder S; S.init(G, bid, 4096);
        pg8::EpiRes E{Y, Y + (size_t)TP * 1024, Y, DN_ALPHA, SLAB};
        pg8::gemm_phase<pg8::EpiRes, pg8::SplitOrder, true, true>(lds, g, S, E); }
    SEAM(15);
    if (RUN(16)) phase_ln(Y, Y + (size_t)TP * 1024, SLAB, Y, nullptr, p.in[23] + 1024, p.in[24] + 1024);
    if (p.ph_lo > 1000) grid.sync();
}

#ifndef ONE_LAUNCH
#define ONE_LAUNCH 0
#endif
extern "C" void kernel_launch(void* const* d_in, const int* in_sizes, int n_in, void* d_out, int out_size, void* d_ws, size_t ws_size, hipStream_t stream) {
    static int grid = 0;
    if (grid == 0) {
        if (n_in != 25 || ws_size < WS_NEED) { fprintf(stderr, "kernel_launch: unexpected n_in %d / ws_size %zu\n", n_in, ws_size); grid = -1; return; }
        int dev = 0, cus = 0, per_cu = 0;
        hipGetDevice(&dev); hipDeviceGetAttribute(&cus, hipDeviceAttributeMultiprocessorCount, dev);
        if (hipFuncSetAttribute((const void*)fwd_kernel, hipFuncAttributeMaxDynamicSharedMemorySize, LDS_BYTES) != hipSuccess) { fprintf(stderr, "kernel_launch: hipFuncSetAttribute failed\n"); grid = -1; return; }
        hipOccupancyMaxActiveBlocksPerMultiprocessor(&per_cu, (const void*)fwd_kernel, 512, LDS_BYTES);
        if (per_cu < 1) { fprintf(stderr, "kernel_launch: occupancy query says %d blocks per CU\n", per_cu); per_cu = 1; }
        (void)hipGetLastError();
        grid = cus;
        if (grid != 256) { fprintf(stderr, "kernel_launch: built for a 256-CU device (got %d)\n", cus); grid = -1; return; }
    }
    if (grid < 0) return;
    if (hipMemsetAsync((char*)d_ws + WS_BAR, 0, 16384, stream) != hipSuccess) { fprintf(stderr, "kernel_launch: memset failed\n"); return; }
    if (hipMemsetAsync((char*)d_ws + WS_VST, 0, 147456, stream) != hipSuccess) { fprintf(stderr, "kernel_launch: memset failed\n"); return; }
    Params p{};
    for (int i = 0; i < 25; ++i) p.in[i] = (const float*)d_in[i];
    p.out = (float*)d_out; p.ws = (unsigned char*)d_ws;
#if ONE_LAUNCH
    p.ph_lo = 0; p.ph_hi = NPHASE - 1;
    void* args[] = {&p};
    hipError_t e = hipLaunchCooperativeKernel((const void*)fwd_kernel, dim3(grid), dim3(512), args, LDS_BYTES, stream);
    if (e != hipSuccess) fprintf(stderr, "cooperative launch failed: %s (grid %d)\n", hipGetErrorString(e), grid);
#else
    for (int ph = 0; ph < NPHASE; ++ph) { p.ph_lo = ph; p.ph_hi = ph; hipLaunchKernelGGL(fwd_kernel, dim3(grid), dim3(512), LDS_BYTES, stream, p); }
#endif
}
```
